# Optimizing an MI355X kernel written in HIP

```python
import jax, jax.numpy as jnp
from jax import lax
import numpy as np

D_MODEL = 1024
BATCH = 8
SEQ = 2048
DEPTH = 2

GRID_W = 64
CTX_LEN = 256
MIX_W = D_MODEL
FN_W = MIX_W // 4
FN_GROUPS = 4
FN_GD = FN_W // FN_GROUPS
NA_HD = 64
NA_W = 3 * MIX_W // 8
NA_HEADS = NA_W // NA_HD
NA_KH = 8
NA_KW = 16
GLA_HEADS = 4
GLA_V_W = MIX_W - FN_W - NA_W
GLA_DV = GLA_V_W // GLA_HEADS
GLA_QK_W = GLA_V_W // 2
GLA_DK = GLA_QK_W // GLA_HEADS
GLA_RANK = 16
GLA_GATE_NORM = 16.0
GLA_CHUNK = 64
ROPE_BASE = 10000.0
D_FF = ((8 * D_MODEL // 3 + 255) // 256) * 256
N_IN = FN_W + 3 * NA_W + 2 * GLA_QK_W + 2 * GLA_V_W + 2 * GLA_RANK
EPS = 1e-6

kernel_name = "hybrid_fnet_natten_gla_prefix_block"

F32 = jnp.float32


def rms_norm(x, gain):
    xf = x.astype(F32)
    y = xf * lax.rsqrt(jnp.mean(xf * xf, axis=-1, keepdims=True) + EPS)
    return (y * gain.astype(F32)).astype(x.dtype)


def ada_modulate(x, gain, shift, scale):
    return rms_norm(x, gain) * (1.0 + scale) + shift


def split_in(z):
    sizes = (FN_W, NA_W, NA_W, NA_W, GLA_QK_W, GLA_QK_W, GLA_V_W, GLA_V_W, 2 * GLA_RANK)
    points = [int(p) for p in np.cumsum(sizes)[:-1]]
    return jnp.split(z, points, axis=-1)


def rope_axis(x, pos):
    m = x.shape[-1] // 2
    inv = ROPE_BASE ** (-jnp.arange(m, dtype=F32) / m)
    ang = pos[:, None] * inv[None, :]
    cos = jnp.cos(ang)[None, :, None, :]
    sin = jnp.sin(ang)[None, :, None, :]
    x1, x2 = x[..., :m], x[..., m:]
    return jnp.concatenate([x1 * cos - x2 * sin, x2 * cos + x1 * sin], axis=-1)


def rope_2d(x):
    L = x.shape[1]
    t = jnp.arange(L)
    row = (t // GRID_W).astype(F32)
    col = (t % GRID_W).astype(F32)
    h = x.shape[-1] // 2
    xf = x.astype(F32)
    return jnp.concatenate([rope_axis(xf[..., :h], row), rope_axis(xf[..., h:], col)], axis=-1).astype(x.dtype)


def fourier_mix(u, w):
    B, L, _ = u.shape
    z = u.astype(F32).reshape(B, L, FN_GROUPS, FN_GD)
    f = jnp.fft.fftn(z, axes=(1, 3), norm="ortho").real
    return f.reshape(B, L, FN_W).astype(u.dtype) @ w


def na_latent(q, k, v, kc, vc, rpb):
    B, L, H, d = q.shape
    R = L // GRID_W
    kh = min(NA_KH, R)
    scale = d ** -0.5
    to_grid = lambda t: t.reshape(B, R, GRID_W, H, d).transpose(0, 3, 1, 2, 4)
    qg, kg, vg = to_grid(q), to_grid(k), to_grid(v)
    r = jnp.arange(R)
    r0 = jnp.clip(r - kh // 2, 0, R - kh)
    row_idx = r0[:, None] + jnp.arange(kh)[None, :]
    kb = kg[:, :, row_idx]
    vb = vg[:, :, row_idx]
    cq = jnp.arange(GRID_W)
    c0 = jnp.clip(cq - NA_KW // 2, 0, GRID_W - NA_KW)
    col_ok = (cq[None, :] >= c0[:, None]) & (cq[None, :] < c0[:, None] + NA_KW)
    dr = row_idx - r[:, None] + NA_KH - 1
    dc = jnp.clip(cq[None, :] - cq[:, None], -(NA_KW - 1), NA_KW - 1) + NA_KW - 1
    bias = rpb[:, dr[:, None, :, None], dc[None, :, None, :]]
    s_loc = jnp.einsum('bhrqd,bhrakd->bhrqak', qg, kb, preferred_element_type=F32) * scale + bias.astype(F32)
    s_loc = jnp.where(col_ok[:, None, :], s_loc, -jnp.inf)
    s_ctx = jnp.einsum('bhrqd,bnhd->bhrqn', qg, kc, preferred_element_type=F32) * scale
    n_loc = kh * GRID_W
    s = jnp.concatenate([s_loc.reshape(B, H, R, GRID_W, n_loc), s_ctx], axis=-1)
    p = jax.nn.softmax(s, axis=-1).astype(v.dtype)
    p_loc = p[..., :n_loc].reshape(B, H, R, GRID_W, kh, GRID_W)
    o = (jnp.einsum('bhrqak,bhrakd->bhrqd', p_loc, vb)
         + jnp.einsum('bhrqn,bnhd->bhrqd', p[..., n_loc:], vc))
    return o.transpose(0, 2, 3, 1, 4).reshape(B, L, H * d)


def ctx_attn(q, k, v):
    B, N, H, d = q.shape
    s = jnp.einsum('bnhd,bmhd->bhnm', q, k, preferred_element_type=F32) * (d ** -0.5)
    p = jax.nn.softmax(s, axis=-1).astype(v.dtype)
    return jnp.einsum('bhnm,bmhd->bnhd', p, v).reshape(B, N, H * d)


def gla_chunked(q, k, v, glog, s0, need_out):
    B, L, H, dk = k.shape
    dv = v.shape[-1]
    n = L // GLA_CHUNK
    blk = lambda t: t.reshape(B, n, GLA_CHUNK, H, t.shape[-1]).transpose(1, 0, 3, 2, 4)
    kb, vb, gb = blk(k), blk(v), blk(glog)
    b = jnp.cumsum(gb, axis=3)
    b_last = b[:, :, :, -1:, :]
    decay = jnp.exp(b_last)
    k_end = kb * jnp.exp(b_last - b)
    if not need_out:
        def step_state(S, xs):
            ke, vi, dl = xs
            return S * jnp.swapaxes(dl, -1, -2) + jnp.einsum('bhcd,bhcv->bhdv', ke, vi), None
        S, _ = lax.scan(step_state, s0, (k_end, vb, decay))
        return None, S
    qb = blk(q)
    q_in = qb * jnp.exp(b)
    k_in = kb * jnp.exp(-b)
    mask = jnp.tril(jnp.ones((GLA_CHUNK, GLA_CHUNK), dtype=bool))
    att = jnp.where(mask, jnp.einsum('nbhcd,nbhsd->nbhcs', q_in, k_in), 0.0)
    o_intra = jnp.einsum('nbhcs,nbhsv->nbhcv', att, vb)

    def step(S, xs):
        qi, ke, vi, dl = xs
        o = jnp.einsum('bhcd,bhdv->bhcv', qi, S)
        return S * jnp.swapaxes(dl, -1, -2) + jnp.einsum('bhcd,bhcv->bhdv', ke, vi), o

    S, o_inter = lax.scan(step, s0, (q_in, k_end, vb, decay))
    o = (o_intra + o_inter).transpose(1, 0, 3, 2, 4).reshape(B, L, H, dv)
    return o, S


def gla_prep(q, k, v, a, alpha_w, alpha_b, rope):
    B, L, _ = q.shape
    q = q.astype(F32).reshape(B, L, GLA_HEADS, GLA_DK)
    k = k.astype(F32).reshape(B, L, GLA_HEADS, GLA_DK)
    v = v.astype(F32).reshape(B, L, GLA_HEADS, GLA_DV)
    if rope:
        q = rope_2d(q)
        k = rope_2d(k)
    q = q * (GLA_DK ** -0.5)
    a = a.astype(F32).reshape(B, L, 2, GLA_RANK)
    logits = jnp.einsum('bldr,drk->bldk', a, alpha_w.astype(F32)) + alpha_b.astype(F32)
    glog = (jax.nn.log_sigmoid(logits) / GLA_GATE_NORM).reshape(B, L, 2, GLA_HEADS, GLA_DK)
    return q, k, v, glog[:, :, 0], glog[:, :, 1]


def gla_out(o, g, gain):
    B, L = o.shape[:2]
    on = rms_norm(o, gain).reshape(B, L, GLA_V_W)
    return (on * jax.nn.silu(g.astype(F32))).astype(g.dtype)


def gla_mix(zx, zc, alpha_w, alpha_b, o_norm, need_ctx):
    qx, kx, vx, gx, ax = zx
    qc, kc, vc, gc, ac = zc
    q, k, v, gf, gb = gla_prep(qx, kx, vx, ax, alpha_w, alpha_b, rope=True)
    q_c, k_c, v_c, gfc, gbc = gla_prep(qc, kc, vc, ac, alpha_w, alpha_b, rope=False)
    s0 = jnp.zeros((q.shape[0], GLA_HEADS, GLA_DK, GLA_DV), F32)
    rev = lambda t: t[:, ::-1]
    oc_f, sc_f = gla_chunked(q_c, k_c, v_c, gfc, s0, need_ctx)
    oc_b, sc_b = gla_chunked(rev(q_c), rev(k_c), rev(v_c), rev(gbc), s0, need_ctx)
    ox_f, _ = gla_chunked(q, k, v, gf, sc_f, True)
    ox_b, _ = gla_chunked(rev(q), rev(k), rev(v), rev(gb), sc_b, True)
    y_x = gla_out(ox_f + rev(ox_b), gx, o_norm)
    y_c = gla_out(oc_f + rev(oc_b), gc, o_norm) if need_ctx else None
    return y_x, y_c


def swiglu(h, w1, w3, w2):
    return (jax.nn.silu(h @ w1) * (h @ w3)) @ w2


def hybrid_layer(x, cx, c, c_ctx, ada_w, ada_b, norm_mix, norm_ffn, w_in, fnet_w,
                 na_q_norm, na_k_norm, na_rpb, gla_alpha_w, gla_alpha_b, gla_o_norm,
                 w_out, ffn_w1, ffn_w3, ffn_w2, need_ctx):
    mod_x = (jax.nn.silu(c) @ ada_w + ada_b)[:, None, :]
    mod_c = (jax.nn.silu(c_ctx) @ ada_w + ada_b)[None, None, :]
    sh_m, sc_m, g_m, sh_f, sc_f, g_f = jnp.split(mod_x, 6, axis=-1)
    csh_m, csc_m, cg_m, csh_f, csc_f, cg_f = jnp.split(mod_c, 6, axis=-1)

    hx = ada_modulate(x, norm_mix, sh_m, sc_m)
    hc = ada_modulate(cx, norm_mix, csh_m, csc_m)
    fx, nqx, nkx, nvx, gqx, gkx, gvx, ggx, gax = split_in(hx @ w_in)
    fc, nqc, nkc, nvc, gqc, gkc, gvc, ggc, gac = split_in(hc @ w_in)

    heads = lambda t: t.reshape(t.shape[0], t.shape[1], NA_HEADS, NA_HD)
    y_fn = fourier_mix(fx, fnet_w)
    qxh, kxh, vxh = rms_norm(heads(nqx), na_q_norm), rms_norm(heads(nkx), na_k_norm), heads(nvx)
    qch, kch, vch = rms_norm(heads(nqc), na_q_norm), rms_norm(heads(nkc), na_k_norm), heads(nvc)
    y_na = na_latent(qxh, kxh, vxh, kch, vch, na_rpb)
    y_gla, yc_gla = gla_mix((gqx, gkx, gvx, ggx, gax), (gqc, gkc, gvc, ggc, gac),
                            gla_alpha_w, gla_alpha_b, gla_o_norm, need_ctx)

    y = jnp.concatenate([y_fn, y_na, y_gla.astype(y_fn.dtype)], axis=-1) @ w_out
    x = x + (g_m * y).astype(x.dtype)
    x = x + (g_f * swiglu(ada_modulate(x, norm_ffn, sh_f, sc_f), ffn_w1, ffn_w3, ffn_w2)).astype(x.dtype)

    if need_ctx:
        yc = jnp.concatenate([fourier_mix(fc, fnet_w), ctx_attn(qch, kch, vch),
                              yc_gla.astype(fc.dtype)], axis=-1) @ w_out
        cx = cx + (cg_m * yc).astype(cx.dtype)
        cx = cx + (cg_f * swiglu(ada_modulate(cx, norm_ffn, csh_f, csc_f), ffn_w1, ffn_w3, ffn_w2)).astype(cx.dtype)
    return x, cx


def setup_inputs(seed: int = 0) -> dict:
    key = jax.random.key(seed)
    ks = jax.random.split(key, 20)
    nrm = lambda k, shape, s: jax.random.normal(k, shape, F32) * s
    return {
        "x": nrm(ks[0], (BATCH, SEQ, D_MODEL), 1.0),
        "c": nrm(ks[1], (BATCH, D_MODEL), 1.0),
        "ctx": nrm(ks[2], (BATCH, CTX_LEN, D_MODEL), 1.0),
        "c_ctx": nrm(ks[3], (D_MODEL,), 1.0),
        "ada_w": nrm(ks[4], (DEPTH, D_MODEL, 6 * D_MODEL), 0.5 * D_MODEL ** -0.5),
        "ada_b": nrm(ks[5], (DEPTH, 6 * D_MODEL), 0.01),
        "norm_mix": 1.0 + nrm(ks[6], (DEPTH, D_MODEL), 0.02),
        "norm_ffn": 1.0 + nrm(ks[7], (DEPTH, D_MODEL), 0.02),
        "w_in": nrm(ks[8], (DEPTH, D_MODEL, N_IN), D_MODEL ** -0.5),
        "fnet_w": nrm(ks[9], (DEPTH, FN_W, FN_W), FN_W ** -0.5),
        "na_q_norm": 1.0 + nrm(ks[10], (DEPTH, NA_HD), 0.02),
        "na_k_norm": 1.0 + nrm(ks[11], (DEPTH, NA_HD), 0.02),
        "na_rpb": nrm(ks[12], (DEPTH, NA_HEADS, 2 * NA_KH - 1, 2 * NA_KW - 1), 0.1),
        "gla_alpha_w": nrm(ks[13], (DEPTH, 2, GLA_RANK, GLA_QK_W), GLA_RANK ** -0.5),
        "gla_alpha_b": nrm(ks[14], (DEPTH, 2, GLA_QK_W), 0.1),
        "gla_o_norm": 1.0 + nrm(ks[15], (DEPTH, GLA_DV), 0.02),
        "w_out": nrm(ks[16], (DEPTH, MIX_W, D_MODEL), MIX_W ** -0.5),
        "ffn_w1": nrm(ks[17], (DEPTH, D_MODEL, D_FF), D_MODEL ** -0.5),
        "ffn_w3": nrm(ks[18], (DEPTH, D_MODEL, D_FF), D_MODEL ** -0.5),
        "ffn_w2": nrm(ks[19], (DEPTH, D_FF, D_MODEL), D_FF ** -0.5),
    }


def reference(x, c, ctx, c_ctx, ada_w, ada_b, norm_mix, norm_ffn, w_in, fnet_w,
              na_q_norm, na_k_norm, na_rpb, gla_alpha_w, gla_alpha_b, gla_o_norm,
              w_out, ffn_w1, ffn_w3, ffn_w2):
    cx = ctx
    for l in range(DEPTH):
        x, cx = hybrid_layer(x, cx, c, c_ctx, ada_w[l], ada_b[l], norm_mix[l], norm_ffn[l],
                             w_in[l], fnet_w[l], na_q_norm[l], na_k_norm[l], na_rpb[l],
                             gla_alpha_w[l], gla_alpha_b[l], gla_o_norm[l], w_out[l],
                             ffn_w1[l], ffn_w3[l], ffn_w2[l], need_ctx=(l < DEPTH - 1))
    return x
```

```cpp
#include <hip/hip_runtime.h>
#include <hip/hip_cooperative_groups.h>
#include <cstdio>
namespace cg = cooperative_groups;

#define LAS __attribute__((address_space(3)))
typedef unsigned short bf16_t;
typedef short bf16x8 __attribute__((ext_vector_type(8)));
typedef float f32x4 __attribute__((ext_vector_type(4)));
typedef unsigned u32x4 __attribute__((ext_vector_type(4)));
typedef unsigned u32x2 __attribute__((ext_vector_type(2)));

constexpr int DM = 1024, MLAT = 16384, MALL = 18432, DFF = 2816, NINW = 2592;
constexpr int ZLD = 1568;
constexpr int ZC_NK = 384, ZC_GQ = 768, ZC_GK = 960, ZC_GG = 1152, ZC_GA = 1536;
constexpr int TC_NV = 256, TC_GV = 640;
constexpr float LOG2E = 1.4426950408889634f;
constexpr int LDS_BYTES = 147456;
constexpr int QWORD_OFF = LDS_BYTES - 16;

constexpr size_t OFF_XCTX = 0;
constexpr size_t OFF_HY   = OFF_XCTX + (size_t)2048 * 1024 * 4;
constexpr size_t OFF_Z    = OFF_HY + (size_t)MALL * 1024 * 2;
constexpr size_t OFF_TLAT = OFF_Z + (size_t)MALL * ZLD * 2;
constexpr size_t OFF_TCTX = OFF_TLAT + (size_t)8 * 1024 * 2048 * 2;
constexpr size_t OFF_PQ   = OFF_TCTX + (size_t)8 * 1024 * 256 * 2;
constexpr size_t OFF_S    = OFF_PQ + (size_t)MALL * 512 * 2;
constexpr size_t OFF_U    = OFF_Z;
static_assert((size_t)MALL * DFF * 2 <= OFF_S - OFF_Z, "U alias");
constexpr size_t OFF_DEC  = OFF_S + (size_t)2304 * 4608 * 2;
constexpr size_t OFF_WSW  = OFF_DEC + (size_t)2304 * 48 * 4;
constexpr size_t OFF_WZ   = OFF_WSW + (size_t)1024 * 1024 * 2;
constexpr size_t OFF_W13  = OFF_WZ + (size_t)1792 * 1024 * 2;
constexpr size_t OFF_WOUT = OFF_W13 + (size_t)5632 * 1024 * 2;
constexpr size_t OFF_W2   = OFF_WOUT + (size_t)1024 * 1024 * 2;
constexpr size_t OFF_WF   = OFF_W2 + (size_t)1024 * 2816 * 2;
constexpr size_t WSET     = OFF_WF + (size_t)256 * 512 * 2 - OFF_WSW;
constexpr size_t OFF_XB   = OFF_WSW + WSET;
constexpr size_t OFF_TL   = OFF_XB + (size_t)MALL * 1024 * 2;
constexpr size_t OFF_TC   = OFF_TL + (size_t)4096 * 2048 * 2;
constexpr size_t OFF_MOD  = OFF_TC + (size_t)512 * 256 * 2;
constexpr size_t OFF_ROPE = OFF_MOD + (size_t)2 * 9 * 6144 * 4;
constexpr size_t OFF_CTR  = OFF_ROPE + 64 * 12 * 8;
constexpr size_t OFF_BAR  = OFF_CTR + 256;
constexpr size_t WS_END   = OFF_BAR + 13824;
static_assert(WS_END <= (size_t)256 * 1024 * 1024, "workspace");

struct Params {
    const float *x, *c, *ctx, *c_ctx, *ada_w, *ada_b, *norm_mix, *norm_ffn, *w_in, *fnet_w, *na_q_norm, *na_k_norm, *na_rpb,
        *gla_alpha_w, *gla_alpha_b, *gla_o_norm, *w_out, *ffn_w1, *ffn_w3, *ffn_w2;
    float* out; unsigned char* ws;
};
__device__ __forceinline__ Params ldp() {
#if defined(__HIP_DEVICE_COMPILE__)
    typedef const __attribute__((address_space(4))) unsigned long long* kptr;
    kptr kp = (kptr)__builtin_amdgcn_kernarg_segment_ptr(); asm volatile("" : "+s"(kp));
    Params r; unsigned long long* d = (unsigned long long*)&r;
#pragma unroll
    for (int i = 0; i < 22; ++i) d[i] = (unsigned long long)(float*)(__attribute__((address_space(1))) float*)kp[i];
    return r;
#else
    return Params{};
#endif
}

__device__ __forceinline__ unsigned pk_bf16(float lo, float hi) { unsigned r; asm volatile("v_cvt_pk_bf16_f32 %0, %1, %2" : "=v"(r) : "v"(lo), "v"(hi)); return r; }
__device__ __forceinline__ bf16_t f2bf(float f) { unsigned u = __float_as_uint(f); u += 0x7FFFu + ((u >> 16) & 1u); return (bf16_t)(u >> 16); }
__device__ __forceinline__ float bf2f(bf16_t h) { return __uint_as_float(((unsigned)h) << 16); }
__device__ __forceinline__ float bflo(unsigned w) { return __uint_as_float(w << 16); }
__device__ __forceinline__ float bfhi(unsigned w) { return __uint_as_float(w & 0xffff0000u); }
__device__ __forceinline__ f32x4 mfma16(bf16x8 a, bf16x8 b, f32x4 c) { return __builtin_amdgcn_mfma_f32_16x16x32_bf16(a, b, c, 0, 0, 0); }
__device__ __forceinline__ bf16x8 as_bf8(u32x4 w) { return __builtin_bit_cast(bf16x8, w); }
__device__ __forceinline__ void st16_wt(void* p, u32x4 v) { *(u32x4*)p = v; }
__device__ __forceinline__ int otid(int wv) { int ln; asm volatile("v_mbcnt_lo_u32_b32 %0, -1, 0\n\tv_mbcnt_hi_u32_b32 %0, -1, %0" : "=v"(ln)); return wv * 64 + ln; }
__device__ __forceinline__ float shx(float v, int m, int lane) { return __int_as_float(__builtin_amdgcn_ds_bpermute((lane ^ m) << 2, __float_as_int(v))); }

__device__ __forceinline__ float xmax16(float v) { const auto r = __builtin_amdgcn_permlane16_swap(__float_as_uint(v), __float_as_uint(v), false, false); return fmaxf(__uint_as_float(r[0]), __uint_as_float(r[1])); }
__device__ __forceinline__ float xmax32(float v) { const auto r = __builtin_amdgcn_permlane32_swap(__float_as_uint(v), __float_as_uint(v), false, false); return fmaxf(__uint_as_float(r[0]), __uint_as_float(r[1])); }
__device__ __forceinline__ float xsum16(float v) { const auto r = __builtin_amdgcn_permlane16_swap(__float_as_uint(v), __float_as_uint(v), false, false); return __uint_as_float(r[0]) + __uint_as_float(r[1]); }
__device__ __forceinline__ float xsum32(float v) { const auto r = __builtin_amdgcn_permlane32_swap(__float_as_uint(v), __float_as_uint(v), false, false); return __uint_as_float(r[0]) + __uint_as_float(r[1]); }

namespace g8 {
constexpr int BM = 256, BK = 64, HALF = 128, HTB = HALF * BK * 2;
__device__ __forceinline__ int lds_byte(int r, int c) { const int st = (r >> 4) * 2 + (c >> 5), rr = r & 15, cc = c & 31, ob = rr * 64 + cc * 2; return st * 1024 + (ob ^ (((ob >> 9) & 1) << 5)); }
__device__ __forceinline__ void stage_rc(int b, int& R, int& C) { const int st = b / 1024, sb = b % 1024, swz = sb ^ (((sb >> 9) & 1) << 5); R = (st >> 1) * 16 + swz / 64; C = (st & 1) * 32 + (swz % 64) / 2; }
__device__ __forceinline__ int perm32(int rho) { const int n = rho >> 4, i = rho & 15; return 8 * (i >> 2) + 4 * n + (i & 3); }

struct Unit { const char* a; const char* b; char* o; const float* p1; const float* p2; int ldo; int cmax; int nt; int mode; int half; int mk; int mneg; };

struct ListOrder {
    int n, G, c;
    __device__ __forceinline__ bool idx(int i, int& Lp) const {
        const long L = (long)i * G + c; if (L >= n) return false;
        const int w = (int)L, q = n / 8, r = n % 8, xcd = w % 8, off = w / 8;
        Lp = (xcd < r ? xcd * (q + 1) : r * (q + 1) + (xcd - r) * q) + off; return true;
    }
};

struct ListOrderH {
    int n, G, c;
    __device__ __forceinline__ bool idx(int i, int& Lp, int& half) const {
        const int R = n / G, T = n % G; long L; half = 0;
        if (i == R && T > 0 && 2 * T <= G) { if (c >= 2 * T) return false; L = (long)R * G + (c >> 1); half = 1 + (c & 1); }
        else { L = (long)i * G + c; if (L >= n) return false; }
        const int w = (int)L, q = n / 8, r = n % 8, xcd = w % 8, off = w / 8;
        Lp = (xcd < r ? xcd * (q + 1) : r * (q + 1) + (xcd - r) * q) + off; return true;
    }
};

template <class Epi, class Sched>
__device__ __forceinline__ void gemm_phase(int wv, LAS unsigned char* lds, const int K, const Sched& S, const Epi& E) {
    const int tid = otid(wv), wid = __builtin_amdgcn_readfirstlane(tid >> 6), lane = tid & 63, wr = wid >> 2, wc = wid & 3, fr = lane & 15, fq = lane >> 4;
    unsigned voffA[2], voffB[2];
#pragma unroll
    for (int i = 0; i < 2; ++i) { int R, C; stage_rc(tid * 16 + i * 8192, R, C); const int Rb = Epi::PERM ? ((R & ~31) + perm32(R & 31)) : R;
        voffA[i] = (unsigned)(R * K + C) * 2u; voffB[i] = (unsigned)(Rb * K + C) * 2u; }
    const size_t kstep = (size_t)(BK * 2);
    const size_t hstep = (size_t)HALF * K * 2;
    const unsigned ldsw = (unsigned)wid * 1024u;
    const int aoff = lds_byte(wr * 64 + fr, fq * 8), boff = lds_byte(wc * 32 + fr, fq * 8);
#define G8_SA(b, h) (((b) * 2 + (h)) * HTB)
#define G8_SB(b, h) ((4 + (b) * 2 + (h)) * HTB)
#define G8_STAGE(bufoff, gbase, voff) do { _Pragma("unroll") for (int _i = 0; _i < 2; ++_i) \
        __builtin_amdgcn_global_load_lds((const unsigned*)((const char*)(gbase) + (voff)[_i]), (LAS unsigned*)(lds + (bufoff) + ldsw + _i * 8192), 16, 0, 0); } while (0)
#define G8_LDA(dst, b, h) do { _Pragma("unroll") for (int m = 0; m < 4; ++m) _Pragma("unroll") for (int k = 0; k < 2; ++k) dst[m][k] = *(const LAS bf16x8*)(lds + G8_SA(b, h) + aoff + m * 2048 + k * 1024); } while (0)
#define G8_LDB(dst, b, h) do { _Pragma("unroll") for (int n = 0; n < 2; ++n) _Pragma("unroll") for (int k = 0; k < 2; ++k) dst[n][k] = *(const LAS bf16x8*)(lds + G8_SB(b, h) + boff + n * 2048 + k * 1024); } while (0)
#define G8_MMA(ai, bj, At, Bt) do { __builtin_amdgcn_s_setprio(1); _Pragma("unroll") for (int m = 0; m < 4; ++m) _Pragma("unroll") for (int n = 0; n < 2; ++n) _Pragma("unroll") for (int k = 0; k < 2; ++k) \
        acc[ai][bj][m][n] = __builtin_amdgcn_mfma_f32_16x16x32_bf16(Bt[n][k], At[m][k], acc[ai][bj][m][n], 0, 0, 0); __builtin_amdgcn_s_setprio(0); } while (0)
#define G8_WAIT_V(n) asm volatile("s_waitcnt vmcnt(" #n ")" ::: "memory")
#define G8_WAIT_L(n) asm volatile("s_waitcnt lgkmcnt(" #n ")" ::: "memory")
#define G8_BAR __builtin_amdgcn_s_barrier()
#define G8_SCHED __builtin_amdgcn_sched_barrier(0)
    Unit cur, nxt; int ui = 0;
    if (!S.next(0, cur)) return;
    f32x4 acc[2][2][4][2];
#pragma unroll
    for (int a = 0; a < 2; ++a)
#pragma unroll
        for (int b = 0; b < 2; ++b)
#pragma unroll
            for (int m = 0; m < 4; ++m)
#pragma unroll
                for (int n = 0; n < 2; ++n) acc[a][b][m][n] = (f32x4){0.f, 0.f, 0.f, 0.f};
    bf16x8 At[4][2], B0[2][2], B1[2][2];
    const char* cA = cur.a; const char* cB = cur.b;
    G8_STAGE(G8_SB(0, 0), cB, voffB); G8_STAGE(G8_SA(0, 0), cA, voffA); G8_STAGE(G8_SB(0, 1), cB + hstep, voffB); G8_STAGE(G8_SA(0, 1), cA + hstep, voffA);
    if (wr == 1) G8_BAR;
    G8_WAIT_V(4); G8_BAR;
    G8_STAGE(G8_SB(1, 0), cB + kstep, voffB); G8_STAGE(G8_SA(1, 0), cA + kstep, voffA); G8_STAGE(G8_SB(1, 1), cB + hstep + kstep, voffB);
    G8_WAIT_V(6); G8_BAR;
    for (;;) {
        const bool has_next = S.next(ui + 1, nxt);
        const char* nA = has_next ? nxt.a : cA; const char* nB = has_next ? nxt.b : cB;
        const int nt = cur.nt; const bool full = (cur.half == 0);
        for (int t = 0; t < nt; t += 2) {
            const bool last = (t == nt - 2);
            const char* a1 = cA + (size_t)(t + 1) * kstep;
            const char* a2 = last ? nA : cA + (size_t)(t + 2) * kstep; const char* b2 = last ? nB : cB + (size_t)(t + 2) * kstep;
            const char* a3 = a2 + kstep; const char* b3 = b2 + kstep;
            G8_LDB(B0, 0, 0); G8_SCHED; G8_LDA(At, 0, 0); G8_STAGE(G8_SA(1, 1), a1 + hstep, voffA);
            G8_WAIT_L(8); G8_BAR; G8_WAIT_L(0); G8_MMA(0, 0, At, B0); G8_BAR; G8_SCHED;
            G8_LDB(B1, 0, 1); G8_STAGE(G8_SB(0, 0), b2, voffB);
            G8_BAR; G8_WAIT_L(0); G8_MMA(0, 1, At, B1); G8_BAR;
            if (full) G8_LDA(At, 0, 1); G8_STAGE(G8_SA(0, 0), a2, voffA);
            G8_BAR; G8_WAIT_L(0); if (full) G8_MMA(1, 0, At, B0); G8_BAR; G8_SCHED;
            G8_STAGE(G8_SB(0, 1), b2 + hstep, voffB);
            G8_WAIT_V(6); G8_BAR; if (full) G8_MMA(1, 1, At, B1); G8_BAR;
            G8_LDB(B0, 1, 0); G8_SCHED; G8_LDA(At, 1, 0); G8_STAGE(G8_SA(0, 1), a2 + hstep, voffA);
            G8_WAIT_L(8); G8_BAR; G8_WAIT_L(0); G8_MMA(0, 0, At, B0); G8_BAR; G8_SCHED;
            G8_LDB(B1, 1, 1); G8_STAGE(G8_SB(1, 0), b3, voffB);
            G8_BAR; G8_WAIT_L(0); G8_MMA(0, 1, At, B1); G8_BAR;
            if (full) G8_LDA(At, 1, 1); G8_STAGE(G8_SA(1, 0), a3, voffA);
            G8_BAR; G8_WAIT_L(0); if (full) G8_MMA(1, 0, At, B0); G8_BAR; G8_SCHED;
            G8_STAGE(G8_SB(1, 1), b3 + hstep, voffB);
            G8_WAIT_V(6); G8_BAR; if (full) G8_MMA(1, 1, At, B1); G8_BAR;
        }
        { const int t2 = otid(wv); E(acc, cur, wr, wc, t2 & 15, (t2 >> 4) & 3); }
        if (!has_next) break;
#pragma unroll
        for (int a = 0; a < 2; ++a)
#pragma unroll
            for (int b = 0; b < 2; ++b)
#pragma unroll
                for (int m = 0; m < 4; ++m)
#pragma unroll
                    for (int n = 0; n < 2; ++n) acc[a][b][m][n] = (f32x4){0.f, 0.f, 0.f, 0.f};
        cur = nxt; cA = nA; cB = nB; ++ui;
    }
    G8_WAIT_V(0);
    if (wr == 0) G8_BAR;
    G8_BAR;
#undef G8_SA
#undef G8_SB
#undef G8_STAGE
#undef G8_LDA
#undef G8_LDB
#undef G8_MMA
#undef G8_WAIT_V
#undef G8_WAIT_L
#undef G8_BAR
#undef G8_SCHED
}

struct EpiBf {
    static constexpr bool PERM = true;
    __device__ __forceinline__ void operator()(const f32x4 (&acc)[2][2][4][2], const Unit& u, int wr, int wc, int fr, int fq) const {
        const int row0 = wr * 64 + fr, col0 = wc * 32 + 8 * fq;
#pragma unroll
        for (int ai = 0; ai < 2; ++ai) if (ai == 0 || u.half == 0)
#pragma unroll
            for (int m = 0; m < 4; ++m) { const int rr = row0 + ai * HALF + m * 16; bf16_t* rowp = (bf16_t*)u.o + (size_t)rr * u.ldo + col0;
                const int k = u.mk + rr; const bool mir = (u.mk >= 0) && (k > 0);
                bf16_t* rowm = (bf16_t*)u.p1 + (size_t)(2048 - k) * u.ldo + col0;
#pragma unroll
                for (int bj = 0; bj < 2; ++bj) { if (col0 + bj * HALF < u.cmax) { const f32x4 v0 = acc[ai][bj][m][0], v1 = acc[ai][bj][m][1];
                    u32x4 w; w.x = pk_bf16(v0[0], v0[1]); w.y = pk_bf16(v0[2], v0[3]); w.z = pk_bf16(v1[0], v1[1]); w.w = pk_bf16(v1[2], v1[3]);
                    st16_wt(rowp + bj * HALF, w);
                    if (mir) { const float sg = u.mneg ? -1.f : 1.f; u32x4 w2; w2.x = pk_bf16(v0[0] * sg, v0[1] * sg); w2.y = pk_bf16(v0[2] * sg, v0[3] * sg); w2.z = pk_bf16(v1[0] * sg, v1[1] * sg); w2.w = pk_bf16(v1[2] * sg, v1[3] * sg);
                        st16_wt(rowm + bj * HALF, w2); } } } }
    }
};
struct EpiRes {
    static constexpr bool PERM = true;
    __device__ __forceinline__ void operator()(const f32x4 (&acc)[2][2][4][2], const Unit& u, int wr, int wc, int fr, int fq) const {
        const int row0 = wr * 64 + fr, col0 = wc * 32 + 8 * fq;
        if (u.mode == 0) {
            f32x4 gv[2][2];
#pragma unroll
            for (int bj = 0; bj < 2; ++bj)
#pragma unroll
                for (int n = 0; n < 2; ++n) gv[bj][n] = *(const f32x4*)(u.p2 + col0 + bj * HALF + n * 4);
            const bool bb16 = (u.cmax & 1) != 0, ob16 = (u.cmax & 2) != 0;
            f32x4 bs[2][2][2];
#define RES_LOAD(BUF, OFF) do { _Pragma("unroll") for (int bj = 0; bj < 2; ++bj) { \
                if (bb16) { const u32x4 w = *(const u32x4*)((const bf16_t*)u.p1 + (OFF) + bj * HALF); bs[BUF][bj][0] = (f32x4){bflo(w.x), bfhi(w.x), bflo(w.y), bfhi(w.y)}; bs[BUF][bj][1] = (f32x4){bflo(w.z), bfhi(w.z), bflo(w.w), bfhi(w.w)}; } \
                else { bs[BUF][bj][0] = *(const f32x4*)(u.p1 + (OFF) + bj * HALF); bs[BUF][bj][1] = *(const f32x4*)(u.p1 + (OFF) + bj * HALF + 4); } } } while (0)
            RES_LOAD(0, (size_t)row0 * 1024 + col0);
#pragma unroll
            for (int g = 0; g < 8; ++g) { const int ai = g >> 2, m = g & 3; const size_t off = (size_t)(row0 + ai * HALF + m * 16) * 1024 + col0;
                if (g < 7) { const int ai2 = (g + 1) >> 2, m2 = (g + 1) & 3; const size_t off2 = (size_t)(row0 + ai2 * HALF + m2 * 16) * 1024 + col0;
                    if (g & 1) { RES_LOAD(0, off2); } else { RES_LOAD(1, off2); } }
                asm volatile("" ::: "memory");
#pragma unroll
                for (int bj = 0; bj < 2; ++bj) { const f32x4 x0 = bs[g & 1][bj][0] + gv[bj][0] * acc[ai][bj][m][0], x1 = bs[g & 1][bj][1] + gv[bj][1] * acc[ai][bj][m][1];
                    if (ob16) { u32x4 w; w.x = pk_bf16(x0[0], x0[1]); w.y = pk_bf16(x0[2], x0[3]); w.z = pk_bf16(x1[0], x1[1]); w.w = pk_bf16(x1[2], x1[3]); st16_wt((bf16_t*)u.o + off + bj * HALF, w); }
                    else { st16_wt((float*)u.o + off + bj * HALF, __builtin_bit_cast(u32x4, x0)); st16_wt((float*)u.o + off + bj * HALF + 4, __builtin_bit_cast(u32x4, x1)); } }
                asm volatile("" ::: "memory"); }
#undef RES_LOAD
        } else {
#pragma unroll
            for (int ai = 0; ai < 2; ++ai)
#pragma unroll
                for (int m = 0; m < 4; ++m) { bf16_t* op = (bf16_t*)u.o + (size_t)(row0 + ai * HALF + m * 16) * 1024 + col0;
#pragma unroll
                    for (int bj = 0; bj < 2; ++bj) { const f32x4 v0 = acc[ai][bj][m][0], v1 = acc[ai][bj][m][1];
                        u32x4 w; w.x = pk_bf16(v0[0], v0[1]); w.y = pk_bf16(v0[2], v0[3]); w.z = pk_bf16(v1[0], v1[1]); w.w = pk_bf16(v1[2], v1[3]); st16_wt(op + bj * HALF, w); } }
        }
    }
};
struct EpiSwiglu {
    static constexpr bool PERM = false;
    __device__ __forceinline__ void operator()(const f32x4 (&acc)[2][2][4][2], const Unit& u, int wr, int wc, int fr, int fq) const {
        const int row0 = wr * 64 + fr, col0 = wc * 32 + 8 * fq;
#pragma unroll
        for (int ai = 0; ai < 2; ++ai) if (ai == 0 || u.half == 0)
#pragma unroll
            for (int m = 0; m < 4; ++m) { bf16_t* rowp = (bf16_t*)u.o + (size_t)(row0 + ai * HALF + m * 16) * u.ldo + col0; float r[8];
#pragma unroll
                for (int bj = 0; bj < 2; ++bj) { const f32x4 a = acc[ai][bj][m][0], b = acc[ai][bj][m][1];
#pragma unroll
                    for (int e = 0; e < 4; ++e) r[bj * 4 + e] = a[e] * b[e] * __builtin_amdgcn_rcpf(1.f + __expf(-a[e])); }
                u32x4 w; w.x = pk_bf16(r[0], r[1]); w.y = pk_bf16(r[2], r[3]); w.z = pk_bf16(r[4], r[5]); w.w = pk_bf16(r[6], r[7]); st16_wt(rowp, w); }
    }
};
}
using g8::Unit;

struct SchedInproj {
    g8::ListOrderH L; unsigned char* ws; int l1; size_t wo;
    __device__ __forceinline__ bool next(int i, Unit& u) const {
        int q, hf; if (!L.idx(i, q, hf)) return false;
        const char* H = (const char*)(ws + OFF_HY);
        u.p1 = nullptr; u.p2 = nullptr; u.nt = 16; u.mode = 0; u.half = 0; u.mk = -1; u.mneg = 0;
        int kind, pm, pn, bt = 0;
        if (!l1) { if (q < 504) { kind = 0; const int gid = q / 56, rem = q % 56; pm = gid * 8 + (rem & 7); pn = rem >> 3; } else if (q < 760) { const int s = q - 504; kind = 1; bt = s >> 5; pn = (s & 31) >> 2; pm = s & 3; } else { const int s = q - 760; kind = 2; bt = s >> 2; pm = s & 3; pn = 0; } }
        else { if (q < 448) { kind = 0; const int gid = q / 56, rem = q % 56; pm = gid * 8 + (rem & 7); pn = rem >> 3; } else if (q < 488) { const int s = q - 448, r5 = s % 5; kind = 0; pm = 64 + s / 5; pn = r5 < 4 ? r5 + 1 : 6; }
               else if (q < 744) { const int s = q - 488; kind = 1; bt = s >> 5; pn = (s & 31) >> 2; pm = s & 3; } else { const int s = q - 744; kind = 2; bt = s / 3; pm = 1 + s % 3; pn = 0; } }
        if (kind == 0) {
            u.a = H + (size_t)pm * 256 * 2048; u.b = (const char*)(ws + OFF_WZ + wo) + (size_t)pn * 256 * 2048;
            u.o = (char*)(ws + OFF_Z) + ((size_t)pm * 256 * ZLD + pn * 256) * 2; u.ldo = ZLD; u.cmax = ZLD - pn * 256;
        } else if (kind == 1) {
            u.a = (const char*)(ws + OFF_WSW + wo) + (size_t)pm * 256 * 2048; u.b = H + ((size_t)bt * 2048 + pn * 256) * 2048;
            u.o = (char*)(ws + OFF_TLAT) + (((size_t)bt * 1024 + pm * 256) * 2048 + pn * 256) * 2; u.ldo = 2048; u.cmax = 256;
        } else {
            u.a = (const char*)(ws + OFF_WSW + wo) + (size_t)pm * 256 * 2048; u.b = H + ((size_t)MLAT + bt * 256) * 2048;
            u.o = (char*)(ws + OFF_TCTX) + (((size_t)bt * 1024 + pm * 256) * 256) * 2; u.ldo = 256; u.cmax = 256; }
        if (hf) { u.half = 1; if (hf == 2) { u.a += (size_t)128 * 2048; u.o += (size_t)128 * u.ldo * 2; } }
        return true;
    }
};
struct SchedF1Lat {
    g8::ListOrder L; unsigned char* ws;
    __device__ __forceinline__ bool next(int i, Unit& u) const {
        int q; if (!L.idx(i, q)) return false;
        const int bt = q >> 3, isq = (q >> 2) & 1, pm = q & 3;
        u.a = (const char*)(ws + OFF_TL) + (size_t)(isq * 8 + pm) * 256 * 4096; u.b = (const char*)(ws + OFF_TLAT) + (size_t)bt * 1024 * 4096;
        u.o = (char*)(ws + OFF_PQ) + (((size_t)bt * 2048 + pm * 256) * 512 + isq * 256) * 2; u.ldo = 512; u.cmax = 256; u.p2 = nullptr; u.nt = 32; u.mode = 0; u.half = 0;
        u.p1 = (const float*)((bf16_t*)(ws + OFF_PQ) + ((size_t)bt * 2048) * 512 + isq * 256); u.mk = pm * 256; u.mneg = isq;
        return true;
    }
};
__device__ __forceinline__ void fourier_mid_row(int wv, const Params& p) {
    const int tid = otid(wv), lane = tid & 63, gw = blockIdx.x * 8 + (tid >> 6), nw = gridDim.x * 8;
    const bf16_t* TLAT = (const bf16_t*)(p.ws + OFF_TLAT); bf16_t* PQ = (bf16_t*)(p.ws + OFF_PQ);
    for (int pr = gw; pr < 2048; pr += nw) { const int bt = pr >> 8, ch = pr & 255;
        const bf16_t* src = TLAT + ((size_t)bt * 1024 + ch) * 2048 + lane * 32; float acc = 0.f;
#pragma unroll
        for (int j = 0; j < 4; ++j) { const u32x4 w = *(const u32x4*)(src + j * 8);
            acc += (bflo(w.x) - bfhi(w.x)) + (bflo(w.y) - bfhi(w.y)) + (bflo(w.z) - bfhi(w.z)) + (bflo(w.w) - bfhi(w.w)); }
#pragma unroll
        for (int o = 32; o >= 1; o >>= 1) acc += shx(acc, o, lane);
        if (lane == 0) { PQ[((size_t)bt * 2048 + 1024) * 512 + ch] = f2bf(acc * 0.022097086912079608f); PQ[((size_t)bt * 2048 + 1024) * 512 + 256 + ch] = 0; } }
}
struct SchedF1Ctx {
    g8::ListOrder L; unsigned char* ws;
    __device__ __forceinline__ bool next(int i, Unit& u) const {
        int q; if (!L.idx(i, q)) return false;
        const int bt = q >> 1, pm = q & 1;
        u.a = (const char*)(ws + OFF_TC) + (size_t)pm * 256 * 512; u.b = (const char*)(ws + OFF_TCTX) + (size_t)bt * 1024 * 512;
        u.o = (char*)(ws + OFF_PQ) + (((size_t)MLAT + bt * 256) * 512 + pm * 256) * 2; u.ldo = 512; u.cmax = 256; u.p1 = nullptr; u.p2 = nullptr; u.nt = 4; u.mode = 0; u.half = 0; u.mk = -1; u.mneg = 0;
        return true;
    }
};
struct SchedF2 {
    g8::ListOrder L; unsigned char* ws; size_t wo;
    __device__ __forceinline__ bool next(int i, Unit& u) const {
        int q; if (!L.idx(i, q)) return false;
        u.a = (const char*)(ws + OFF_PQ) + (size_t)q * 256 * 1024; u.b = (const char*)(ws + OFF_WF + wo);
        u.o = (char*)(ws + OFF_HY) + (size_t)q * 256 * 2048; u.ldo = 1024; u.cmax = 256; u.p1 = nullptr; u.p2 = nullptr; u.nt = 8; u.mode = 0; u.half = 0; u.mk = -1; u.mneg = 0;
        return true;
    }
};
struct SchedRes {
    int G, c, with_ctx, nsp, ntk, ntp;
    unsigned char* ws; const char* A; size_t a_tile_bytes; const char* Bt; size_t b_tile_bytes;
    const void* base_lat; void* out_lat; int flags; const float* gate;
    __device__ __forceinline__ bool next(int i, Unit& u) const {
        u.ldo = 1024; u.cmax = flags;
        const int r0 = (256 + G - 1) / G;
        if (i < r0) { g8::ListOrder L{256, G, c}; int q; if (!L.idx(i, q)) return false;
            const int pm = q >> 2, pn = q & 3; const size_t ro = (size_t)pm * 256 * 1024 + pn * 256;
            u.a = A + (size_t)pm * a_tile_bytes; u.b = Bt + (size_t)pn * b_tile_bytes;
            u.p1 = (flags & 1) ? (const float*)((const bf16_t*)base_lat + ro) : (const float*)base_lat + ro;
            u.o = (flags & 2) ? (char*)((bf16_t*)out_lat + ro) : (char*)((float*)out_lat + ro);
            u.p2 = gate + (size_t)(pm >> 3) * 6144 + pn * 256; u.nt = ntk; u.mode = 0; u.half = 0; u.mk = -1; u.mneg = 0; return true; }
        if (!with_ctx) return false;
        g8::ListOrder L{32 * nsp, G, c}; int q; if (!L.idx(i - r0, q)) return false;
        const int un = q / nsp, part = q % nsp, pm = un >> 2, pn = un & 3, k0 = part * ntp; const size_t ro = (size_t)pm * 256 * 1024 + pn * 256;
        u.a = A + (size_t)(64 + pm) * a_tile_bytes + (size_t)k0 * 128; u.b = Bt + (size_t)pn * b_tile_bytes + (size_t)k0 * 128;
        u.p1 = nullptr; u.o = (char*)(ws + OFF_S) + ((size_t)part * 2048 * 1024 + ro) * 2; u.p2 = gate + (size_t)8 * 6144 + pn * 256;
        u.nt = (part == nsp - 1) ? (ntk - k0) : ntp; u.mode = 1; u.half = 0; u.mk = -1; u.mneg = 0; return true;
    }
};
struct SchedFfn1 {
    g8::ListOrderH L; unsigned char* ws; size_t wo;
    __device__ __forceinline__ bool next(int i, Unit& u) const {
        int q, hf; if (!L.idx(i, q, hf)) return false;
        const int gid = q / 176, rem = q % 176, pm = gid * 8 + (rem & 7), pn = rem >> 3;
        u.a = (const char*)(ws + OFF_HY) + (size_t)pm * 256 * 2048; u.b = (const char*)(ws + OFF_W13 + wo) + (size_t)pn * 256 * 2048;
        u.o = (char*)(ws + OFF_U) + ((size_t)pm * 256 * DFF + pn * 128) * 2; u.ldo = DFF; u.cmax = 128; u.p1 = nullptr; u.p2 = nullptr; u.nt = 16; u.mode = 0; u.half = 0; u.mk = -1; u.mneg = 0;
        if (hf) { u.half = 1; if (hf == 2) { u.a += (size_t)128 * 2048; u.o += (size_t)128 * DFF * 2; } }
        return true;
    }
};

__device__ __forceinline__ void phase0(int wv, const Params& p, LAS unsigned char* lds, int cb_first, int cb_stride, int cb_lo, int cb_hi, bool do_rope) {
    const int tid = otid(wv);
    float* mod = (float*)(p.ws + OFF_MOD);
    LAS float* sc = (LAS float*)lds;
    LAS float* part = (LAS float*)(lds + 36864);
    for (int cb = cb_lo + cb_first; cb < cb_hi; cb += cb_stride) {
        __syncthreads();
        for (int e = tid; e < 9216; e += 512) { const int i = e >> 10, k = e & 1023; const float v = (i < 8) ? p.c[i * 1024 + k] : p.c_ctx[k]; sc[e] = v / (1.f + expf(-v)); }
        __syncthreads();
        const int l = cb / 96, nb = cb % 96, nl = tid & 63, ks = tid >> 6;
        const float* w = p.ada_w + ((size_t)l * 1024 + ks * 128) * 6144 + nb * 64 + nl;
        float acc[9];
#pragma unroll
        for (int i = 0; i < 9; ++i) acc[i] = 0.f;
        for (int k0 = 0; k0 < 128; k0 += 16) { float wq[16];
#pragma unroll
            for (int u = 0; u < 16; ++u) wq[u] = w[(size_t)(k0 + u) * 6144];
#pragma unroll
            for (int u = 0; u < 16; ++u)
#pragma unroll
                for (int i = 0; i < 9; ++i) acc[i] += sc[i * 1024 + ks * 128 + k0 + u] * wq[u]; }
#pragma unroll
        for (int i = 0; i < 9; ++i) part[(ks * 9 + i) * 64 + nl] = acc[i];
        __syncthreads();
        for (int e = tid; e < 576; e += 512) { const int i = e >> 6, nn = e & 63; float s = 0.f;
#pragma unroll
            for (int k2 = 0; k2 < 8; ++k2) s += part[(k2 * 9 + i) * 64 + nn];
            mod[((size_t)l * 9 + i) * 6144 + nb * 64 + nn] = s + p.ada_b[l * 6144 + nb * 64 + nn]; }
    }
    const size_t gtid = (size_t)blockIdx.x * 512 + tid;
    if (do_rope && gtid < 768) { const int pos = (int)gtid / 12, i = (int)gtid % 12; float sn, cn; sincosf((float)pos * exp2f(-(float)i * 1.1073093649624542f), &sn, &cn);
        float* rp = (float*)(p.ws + OFF_ROPE) + gtid * 2; rp[0] = cn; rp[1] = sn; }
}

__device__ __forceinline__ void trig_tables(int wv, const Params& p, LAS unsigned char* lds, int first, int nblk) {
    const int tid = otid(wv);
    const size_t gtid = (size_t)first * 512 + tid, gstride = (size_t)nblk * 512;
    __syncthreads();
    LAS float* ct = (LAS float*)lds; LAS float* st = ct + 2048;
    for (int e = tid; e < 2048; e += 512) { const float ang = (float)e * (1.0f / 1024.0f); ct[e] = cospif(ang); st[e] = sinpif(ang); }
    __syncthreads();
    unsigned* TL = (unsigned*)(p.ws + OFF_TL);
    for (size_t e = gtid; e < (size_t)4096 * 1024; e += gstride) {
        const int r = (int)(e >> 10), l0 = (int)(e & 1023) * 2, rr = r & 2047; const LAS float* tb = r < 2048 ? ct : st;
        const float v0 = tb[(rr * l0) & 2047] * 0.022097086912079608f, v1 = tb[(rr * (l0 + 1)) & 2047] * 0.022097086912079608f;
        TL[e] = pk_bf16(v0, v1);
    }
    unsigned* TC = (unsigned*)(p.ws + OFF_TC);
    for (size_t e = gtid; e < (size_t)512 * 128; e += gstride) {
        const int r = (int)(e >> 7), l0 = (int)(e & 127) * 2, rr = r & 255; const LAS float* tb = r < 256 ? ct : st;
        const float v0 = tb[((rr * l0) & 255) * 8] * 0.0625f, v1 = tb[((rr * (l0 + 1)) & 255) * 8] * 0.0625f;
        TC[e] = pk_bf16(v0, v1);
    }
    __syncthreads();
}

__device__ __forceinline__ void phase_norm(int wv, const Params& p, int l, int which, int nrows, int nparts, const float* rgate) {
    const int tid = otid(wv), lane = tid & 63, gw = blockIdx.x * 8 + (tid >> 6), nw = gridDim.x * 8;
    const float* mod = (const float*)(p.ws + OFF_MOD) + (size_t)l * 9 * 6144;
    const float* gain = (which ? p.norm_ffn : p.norm_mix) + l * 1024;
    bf16_t* H = (bf16_t*)(p.ws + OFF_HY);
    const bf16_t* XB = (const bf16_t*)(p.ws + OFF_XB);
    const bool srcf32 = (l == 0 && which == 0); const bool wide = true;
    int cq[4];
#pragma unroll
    for (int q = 0; q < 4; ++q) cq[q] = wide ? (q >> 1) * 512 + lane * 8 + (q & 1) * 4 : q * 256 + lane * 4;
    for (int row0 = gw; row0 < nrows; row0 += 3 * nw) {
        f32x4 v[3][4]; float ss[3];
#pragma unroll
        for (int u = 0; u < 3; ++u) { const int row = row0 + u * nw; ss[u] = 0.f;
            if (row < nrows) { const bool lat = row < MLAT;
                if (srcf32) { const float* src = lat ? p.x + (size_t)row * 1024 : p.ctx + (size_t)(row - MLAT) * 1024;
#pragma unroll
                    for (int q = 0; q < 4; ++q) v[u][q] = *(const f32x4*)(src + cq[q]); }
                else {
#pragma unroll
                    for (int jj = 0; jj < 2; ++jj) { const u32x4 w = *(const u32x4*)(XB + (size_t)row * 1024 + jj * 512 + lane * 8);
                        v[u][2 * jj] = (f32x4){bflo(w.x), bfhi(w.x), bflo(w.y), bfhi(w.y)}; v[u][2 * jj + 1] = (f32x4){bflo(w.z), bfhi(w.z), bflo(w.w), bfhi(w.w)}; } } }
            else {
#pragma unroll
                for (int q = 0; q < 4; ++q) v[u][q] = (f32x4){0.f, 0.f, 0.f, 0.f}; } }
#pragma unroll
        for (int u = 0; u < 3; ++u) { const int row = row0 + u * nw;
            if (row < nrows) { const bool lat = row < MLAT; const bool cpy = (l == 0 && which == 0 && !lat);
                if (!lat && nparts > 0) {
#pragma unroll
                    for (int jj = 0; jj < 2; ++jj) { f32x4 s0 = (f32x4){0.f, 0.f, 0.f, 0.f}, s1 = s0;
                        for (int pt = 0; pt < nparts; ++pt) { const u32x4 w = *(const u32x4*)((const bf16_t*)(p.ws + OFF_S) + (size_t)pt * 2048 * 1024 + (size_t)(row - MLAT) * 1024 + jj * 512 + lane * 8);
                            s0 += (f32x4){bflo(w.x), bfhi(w.x), bflo(w.y), bfhi(w.y)}; s1 += (f32x4){bflo(w.z), bfhi(w.z), bflo(w.w), bfhi(w.w)}; }
                        v[u][2 * jj] += *(const f32x4*)(rgate + cq[2 * jj]) * s0; v[u][2 * jj + 1] += *(const f32x4*)(rgate + cq[2 * jj + 1]) * s1;
                        u32x4 w; w.x = pk_bf16(v[u][2 * jj][0], v[u][2 * jj][1]); w.y = pk_bf16(v[u][2 * jj][2], v[u][2 * jj][3]); w.z = pk_bf16(v[u][2 * jj + 1][0], v[u][2 * jj + 1][1]); w.w = pk_bf16(v[u][2 * jj + 1][2], v[u][2 * jj + 1][3]);
                        *(u32x4*)((bf16_t*)(p.ws + OFF_XB) + (size_t)row * 1024 + jj * 512 + lane * 8) = w; } }
#pragma unroll
                for (int q = 0; q < 4; ++q) {
                    if (cpy) { u32x2 w; w.x = pk_bf16(v[u][q][0], v[u][q][1]); w.y = pk_bf16(v[u][q][2], v[u][q][3]); *(u32x2*)((bf16_t*)(p.ws + OFF_XB) + (size_t)row * 1024 + cq[q]) = w; }
                    ss[u] += v[u][q][0] * v[u][q][0] + v[u][q][1] * v[u][q][1] + v[u][q][2] * v[u][q][2] + v[u][q][3] * v[u][q][3]; } } }
#pragma unroll
        for (int o = 32; o >= 1; o >>= 1) {
#pragma unroll
            for (int u = 0; u < 3; ++u) ss[u] += shx(ss[u], o, lane); }
#pragma unroll
        for (int u = 0; u < 3; ++u) { const int row = row0 + u * nw;
            if (row < nrows) { const bool lat = row < MLAT; const int bi = lat ? (row >> 11) : 8;
                const float* sh = mod + (size_t)bi * 6144 + (which ? 3072 : 0);
                const float* sl = mod + (size_t)bi * 6144 + (which ? 4096 : 1024);
                const float rs = rsqrtf(ss[u] * (1.0f / 1024.0f) + 1e-6f);
                unsigned pk[4][2];
#pragma unroll
                for (int q = 0; q < 4; ++q) { const f32x4 g = *(const f32x4*)(gain + cq[q]), s1 = *(const f32x4*)(sl + cq[q]), s0 = *(const f32x4*)(sh + cq[q]); float r[4];
#pragma unroll
                    for (int e = 0; e < 4; ++e) r[e] = v[u][q][e] * rs * g[e] * (1.f + s1[e]) + s0[e];
                    pk[q][0] = pk_bf16(r[0], r[1]); pk[q][1] = pk_bf16(r[2], r[3]); }
                if (wide) {
#pragma unroll
                    for (int jj = 0; jj < 2; ++jj) { u32x4 w; w.x = pk[2 * jj][0]; w.y = pk[2 * jj][1]; w.z = pk[2 * jj + 1][0]; w.w = pk[2 * jj + 1][1]; *(u32x4*)(H + (size_t)row * 1024 + jj * 512 + lane * 8) = w; } }
                else {
#pragma unroll
                    for (int q = 0; q < 4; ++q) { u32x2 w; w.x = pk[q][0]; w.y = pk[q][1]; *(u32x2*)(H + (size_t)row * 1024 + cq[q]) = w; } } } }
    }
}

__device__ __forceinline__ void phase_weights(int wv, const Params& p, int l, LAS unsigned char* lds, int first, int stride) {
    const size_t wo = (size_t)0 * WSET;
    asm volatile("" : "+s"(stride));
    const int tid = otid(wv);
    LAS float* tile = (LAS float*)lds;
    LAS float* cs = (LAS float*)(lds + 33792);
    if (tid < 64) { cs[tid] = cospif((float)tid * (1.0f / 32.0f)); cs[64 + tid] = sinpif((float)tid * (1.0f / 32.0f)); }
    const int nl = tid & 63, kq = tid >> 6;
    float rg[16];
    const float* sp = nullptr; int ld = 0, k0 = 0, n0 = 0, K = 0; bf16_t* dst = nullptr;
    int ti = first;
#define WT_DECODE(TI) do { int mat; \
        if ((TI) < 1184) { const int nt = (TI) >> 3; k0 = ((TI) & 7) * 128; K = 1024; \
            if (nt < 16) { mat = 0; n0 = nt * 64; dst = (bf16_t*)(p.ws + OFF_WSW + wo); } \
            else if (nt < 44) { mat = 1; n0 = (nt - 16) * 64; dst = (bf16_t*)(p.ws + OFF_WZ + wo); } \
            else if (nt < 132) { mat = 2; n0 = (nt - 44) * 64; dst = (bf16_t*)(p.ws + OFF_W13 + wo); } \
            else { mat = 3; n0 = (nt - 132) * 64; dst = (bf16_t*)(p.ws + OFF_WOUT + wo); } \
        } else { const int t2 = (TI) - 1184; mat = 4; n0 = (t2 / 22) * 64; k0 = (t2 % 22) * 128; K = 2816; dst = (bf16_t*)(p.ws + OFF_W2 + wo); } \
        const int n = n0 + nl; sp = nullptr; ld = 0; \
        if (mat == 0) { const int col = n < 256 ? n : (n < 640 ? 1024 + (n - 256) : 1792 + (n - 640)); sp = p.w_in + (size_t)l * 1024 * NINW + col; ld = NINW; } \
        else if (mat == 1) { if (n < ZLD) { const int col = n < 768 ? 256 + n : (n < 1152 ? 1408 + (n - 768) : 2176 + (n - 1152)); sp = p.w_in + (size_t)l * 1024 * NINW + col; ld = NINW; } } \
        else if (mat == 2) { const int i2 = n & 15, J = (n >> 8) * 128 + ((n >> 5) & 3) * 32 + (i2 >> 2) * 8 + ((n >> 7) & 1) * 4 + (i2 & 3); sp = ((n & 16) ? p.ffn_w3 : p.ffn_w1) + (size_t)l * 1024 * DFF + J; ld = DFF; } \
        else if (mat == 3) { sp = p.w_out + (size_t)l * 1024 * 1024 + n; ld = 1024; } \
        else { sp = p.ffn_w2 + (size_t)l * DFF * 1024 + n; ld = 1024; } } while (0)
#define WT_LOAD() do { _Pragma("unroll") for (int i = 0; i < 16; ++i) rg[i] = sp ? sp[(size_t)(k0 + kq + i * 8) * ld] : 0.f; } while (0)
    if (ti < 1536) { WT_DECODE(ti); WT_LOAD(); }
    while (ti < 1536) {
        bf16_t* cdst = dst + (size_t)n0 * K + k0; const int cK = K;
        __syncthreads();
#pragma unroll
        for (int i = 0; i < 16; ++i) tile[(kq + i * 8) * 65 + nl] = rg[i];
        ti += stride;
        if (ti < 1536) { WT_DECODE(ti); WT_LOAD(); }
        __syncthreads();
        { const int nn = tid >> 3, ks = tid & 7; float v[16];
#pragma unroll
            for (int j = 0; j < 16; ++j) v[j] = tile[(ks * 16 + j) * 65 + nn];
            u32x4 w0, w1; w0.x = pk_bf16(v[0], v[1]); w0.y = pk_bf16(v[2], v[3]); w0.z = pk_bf16(v[4], v[5]); w0.w = pk_bf16(v[6], v[7]);
            w1.x = pk_bf16(v[8], v[9]); w1.y = pk_bf16(v[10], v[11]); w1.z = pk_bf16(v[12], v[13]); w1.w = pk_bf16(v[14], v[15]);
            bf16_t* o = cdst + (size_t)nn * cK + ks * 16; *(u32x4*)o = w0; *(u32x4*)(o + 8) = w1; }
    }
#undef WT_DECODE
#undef WT_LOAD
    __syncthreads();
    bf16_t* WF = (bf16_t*)(p.ws + OFF_WF + wo);
    const float* fw = p.fnet_w + (size_t)l * 65536;
    for (int idx = first * 512 + tid; idx < 131072; idx += stride * 512) {
        const int n = idx & 255, k = idx >> 8, part = k >> 8, g = (k & 255) >> 6, j = k & 63; float s = 0.f;
        for (int m = 0; m < 64; ++m) s += cs[part * 64 + ((m * j) & 63)] * fw[(size_t)(g * 64 + m) * 256 + n];
        WF[(size_t)n * 512 + k] = f2bf(part ? -0.125f * s : 0.125f * s);
    }
}

constexpr int NA_KLOC = 0, NA_VLOC = 36864, NA_KCTX = 70656, NA_VCTX = 89088, NA_RPB = 106496;
__device__ __forceinline__ u32x4 norm_krow(u32x4 w, int lane) {
    float v[8]; v[0] = bflo(w.x); v[1] = bfhi(w.x); v[2] = bflo(w.y); v[3] = bfhi(w.y); v[4] = bflo(w.z); v[5] = bfhi(w.z); v[6] = bflo(w.w); v[7] = bfhi(w.w);
    float ss = 0.f;
#pragma unroll
    for (int e = 0; e < 8; ++e) ss += v[e] * v[e];
    ss += shx(ss, 1, lane); ss += shx(ss, 2, lane); ss += shx(ss, 4, lane);
    const float rk = rsqrtf(ss * (1.0f / 64.0f) + 1e-6f);
    u32x4 o; o.x = pk_bf16(v[0] * rk, v[1] * rk); o.y = pk_bf16(v[2] * rk, v[3] * rk); o.z = pk_bf16(v[4] * rk, v[5] * rk); o.w = pk_bf16(v[6] * rk, v[7] * rk); return o;
}
constexpr int NB_KLOC = 0, NB_VLOC = 46080, NB_KCTX = 88064, NB_VCTX = 106496, NB_RPB = 123904;
template <int ND>
__device__ __forceinline__ void na_step(LAS unsigned char* lds, int kbase, int vbase, int vstr, const int (&key0)[ND], bool loc, const int (&dr)[ND], const LAS float* rpb,
                                        const bf16x8 (&qf)[2], int fr, int fq, int lane, int cst, int cq, int c0w, float& m_run, float& l_run, f32x4 (&O)[4]) {
    f32x4 sc[2 * ND];
#pragma unroll
    for (int u = 0; u < 2 * ND; ++u) sc[u] = (f32x4){0.f, 0.f, 0.f, 0.f};
    __builtin_amdgcn_s_setprio(1);
#pragma unroll
    for (int kk = 0; kk < 2; ++kk)
#pragma unroll
        for (int u = 0; u < 2 * ND; ++u) {
            const bf16x8 kf = *(const LAS bf16x8*)(lds + kbase + (key0[u >> 1] + (u & 1) * 16 + fr) * 144 + kk * 64 + fq * 16);
            sc[u] = mfma16(kf, qf[kk], sc[u]); }
    __builtin_amdgcn_s_setprio(0);
    if (loc) {
#pragma unroll
        for (int g = 0; g < ND; ++g)
#pragma unroll
            for (int i = 0; i < 4; ++i) {
                const int ck0 = cst + fq * 4 + i, ck1 = ck0 + 16;
                const int rel0 = min(max(ck0 - cq + 15, 0), 30), rel1 = min(max(ck1 - cq + 15, 0), 30);
                const bool v0 = (ck0 >= c0w) && (ck0 < c0w + 16), v1 = (ck1 >= c0w) && (ck1 < c0w + 16);
                sc[2 * g][i] = v0 ? sc[2 * g][i] + rpb[dr[g] * 31 + rel0] : -INFINITY;
                sc[2 * g + 1][i] = v1 ? sc[2 * g + 1][i] + rpb[dr[g] * 31 + rel1] : -INFINITY; }
    }
    float mx = -INFINITY;
#pragma unroll
    for (int u = 0; u < 2 * ND; ++u) mx = fmaxf(mx, fmaxf(fmaxf(sc[u][0], sc[u][1]), fmaxf(sc[u][2], sc[u][3])));
    mx = xmax16(mx); mx = xmax32(mx);
    const float m_new = fmaxf(m_run, mx);
    const float m_use = (m_new == -INFINITY) ? 0.f : m_new;
    const float alpha = __builtin_amdgcn_exp2f(m_run - m_use);
    float ps_sum = 0.f; bf16x8 pf[ND];
#pragma unroll
    for (int g = 0; g < ND; ++g) { float pv[8];
#pragma unroll
        for (int i = 0; i < 4; ++i) { pv[i] = __builtin_amdgcn_exp2f(sc[2 * g][i] - m_use); pv[4 + i] = __builtin_amdgcn_exp2f(sc[2 * g + 1][i] - m_use); ps_sum += pv[i] + pv[4 + i]; }
        u32x4 pw; pw.x = pk_bf16(pv[0], pv[1]); pw.y = pk_bf16(pv[2], pv[3]); pw.z = pk_bf16(pv[4], pv[5]); pw.w = pk_bf16(pv[6], pv[7]);
        pf[g] = as_bf8(pw); }
    l_run = l_run * alpha + ps_sum; m_run = m_new;
    __builtin_amdgcn_s_setprio(1);
#pragma unroll
    for (int d = 0; d < 4; ++d) { O[d] = O[d] * alpha;
#pragma unroll
        for (int g = 0; g < ND; ++g) {
            const u32x2 va = *(const LAS u32x2*)(lds + vbase + (d * 16 + fr) * vstr + (key0[g] + fq * 4) * 2);
            const u32x2 vb = *(const LAS u32x2*)(lds + vbase + (d * 16 + fr) * vstr + (key0[g] + 16 + fq * 4) * 2);
            u32x4 vw; vw.x = va.x; vw.y = va.y; vw.z = vb.x; vw.w = vb.y;
            O[d] = mfma16(as_bf8(vw), pf[g], O[d]); } }
    __builtin_amdgcn_s_setprio(0);
}
__device__ __forceinline__ void na_item(int wv, const Params& p, int l, int it, LAS unsigned char* lds) {
    const int tid = otid(wv), lane = tid & 63, wave = __builtin_amdgcn_readfirstlane(tid >> 6), fr = lane & 15, fq = lane >> 4;
    const bf16_t* Z = (const bf16_t*)(p.ws + OFF_Z); const bf16_t* TLAT = (const bf16_t*)(p.ws + OFF_TLAT); const bf16_t* TCTX = (const bf16_t*)(p.ws + OFF_TCTX);
    bf16_t* Y = (bf16_t*)(p.ws + OFF_HY);
    const bool lat = it < 768; int b, h, rho = 0, g2 = 0;
    if (lat) { b = it / 96; const int rem = it % 96; h = rem >> 4; rho = rem & 15; } else { const int ci = it - 768; b = ci / 12; h = (ci % 12) >> 1; g2 = ci & 1; }
    const int r0a = min(max(2 * rho - 4, 0), 24), r0b = min(max(2 * rho - 3, 0), 24), dd = r0b - r0a;
    const int rsel = wave >> 2, j = wave & 3;
    const int r = 2 * rho + rsel, r0 = rsel ? r0b : r0a, off = rsel ? dd : 0;
    const int cst = (j == 0) ? 0 : (j == 1 ? 8 : (j == 2 ? 24 : 32));
    const int qrow = lat ? (b * 2048 + r * 64 + 16 * j + fr) : (MLAT + b * 256 + g2 * 128 + wave * 16 + fr);
    LAS float* rpb = (LAS float*)(lds + NB_RPB);
    bf16x8 qf[2];
    { const bf16_t* qp = Z + (size_t)qrow * ZLD + h * 64 + fq * 8;
      const u32x4 w0 = *(const u32x4*)qp, w1 = *(const u32x4*)(qp + 32);
      float v[16]; v[0] = bflo(w0.x); v[1] = bfhi(w0.x); v[2] = bflo(w0.y); v[3] = bfhi(w0.y); v[4] = bflo(w0.z); v[5] = bfhi(w0.z); v[6] = bflo(w0.w); v[7] = bfhi(w0.w);
      v[8] = bflo(w1.x); v[9] = bfhi(w1.x); v[10] = bflo(w1.y); v[11] = bfhi(w1.y); v[12] = bflo(w1.z); v[13] = bfhi(w1.z); v[14] = bflo(w1.w); v[15] = bfhi(w1.w);
      float ss = 0.f;
#pragma unroll
      for (int e = 0; e < 16; ++e) ss += v[e] * v[e];
      ss = xsum16(ss); ss = xsum32(ss);
      const float rq = rsqrtf(ss * (1.0f / 64.0f) + 1e-6f) * 0.125f * LOG2E;
      const float* gq = p.na_q_norm + l * 64; const float* gk = p.na_k_norm + l * 64;
#pragma unroll
      for (int e = 0; e < 8; ++e) { v[e] *= rq * gq[fq * 8 + e] * gk[fq * 8 + e]; v[8 + e] *= rq * gq[32 + fq * 8 + e] * gk[32 + fq * 8 + e]; }
      u32x4 a, c; a.x = pk_bf16(v[0], v[1]); a.y = pk_bf16(v[2], v[3]); a.z = pk_bf16(v[4], v[5]); a.w = pk_bf16(v[6], v[7]);
      c.x = pk_bf16(v[8], v[9]); c.y = pk_bf16(v[10], v[11]); c.z = pk_bf16(v[12], v[13]); c.w = pk_bf16(v[14], v[15]);
      qf[0] = as_bf8(a); qf[1] = as_bf8(c); }
    float m_run = -INFINITY, l_run = 0.f;
    f32x4 O[4];
#pragma unroll
    for (int d = 0; d < 4; ++d) O[d] = (f32x4){0.f, 0.f, 0.f, 0.f};
    const int cq = 16 * j + fr, c0w = min(max(cq - 8, 0), 48);
    u32x4 kl[5], vl[5], kc[2], vc[2];
#define NA_LOAD(PS) do { \
        if (lat) { const int nk = ((PS) ? 3 + dd : 5) * 64; const int tk0 = b * 2048 + (r0a + 5 * (PS)) * 64; \
            _Pragma("unroll") for (int i = 0; i < 5; ++i) { const int e = tid + i * 512, key = e >> 3, seg = e & 7; \
                kl[i] = (key < nk) ? *(const u32x4*)(Z + (size_t)(tk0 + key) * ZLD + ZC_NK + h * 64 + seg * 8) : (u32x4){0u, 0u, 0u, 0u}; } \
            _Pragma("unroll") for (int i = 0; i < 5; ++i) { const int e = tid + i * 512, d = e / 40, seg = e % 40; \
                vl[i] = (seg * 8 < nk) ? *(const u32x4*)(TLAT + ((size_t)(b * 1024 + TC_NV + h * 64 + d)) * 2048 + (r0a + 5 * (PS)) * 64 + seg * 8) : (u32x4){0u, 0u, 0u, 0u}; } } \
        _Pragma("unroll") for (int i = 0; i < 2; ++i) { const int e = tid + i * 512, key = e >> 3, seg = e & 7; \
            kc[i] = *(const u32x4*)(Z + (size_t)(MLAT + b * 256 + 128 * (PS) + key) * ZLD + ZC_NK + h * 64 + seg * 8); } \
        _Pragma("unroll") for (int i = 0; i < 2; ++i) { const int e = tid + i * 512, d = e >> 4, seg = e & 15; \
            vc[i] = *(const u32x4*)(TCTX + ((size_t)(b * 1024 + TC_NV + h * 64 + d)) * 256 + 128 * (PS) + seg * 8); } } while (0)
    NA_LOAD(0);
    for (int ps = 0; ps < 2; ++ps) {
        __syncthreads();
        if (ps == 0 && lat) for (int e = tid; e < 465; e += 512) rpb[e] = p.na_rpb[(size_t)(l * 6 + h) * 465 + e] * LOG2E;
        if (lat) {
#pragma unroll
            for (int i = 0; i < 5; ++i) { const int e = tid + i * 512, key = e >> 3, seg = e & 7; *(LAS u32x4*)(lds + NB_KLOC + key * 144 + seg * 16) = norm_krow(kl[i], lane); }
#pragma unroll
            for (int i = 0; i < 5; ++i) { const int e = tid + i * 512, d = e / 40, seg = e % 40; *(LAS u32x4*)(lds + NB_VLOC + d * 656 + seg * 16) = vl[i]; }
        }
#pragma unroll
        for (int i = 0; i < 2; ++i) { const int e = tid + i * 512, key = e >> 3, seg = e & 7; *(LAS u32x4*)(lds + NB_KCTX + key * 144 + seg * 16) = norm_krow(kc[i], lane); }
#pragma unroll
        for (int i = 0; i < 2; ++i) { const int e = tid + i * 512, d = e >> 4, seg = e & 15; *(LAS u32x4*)(lds + NB_VCTX + d * 272 + seg * 16) = vc[i]; }
        __syncthreads();
        if (ps == 0) NA_LOAD(1);
        if (lat) {
            const int p0 = 5 * ps, lo = max(off, p0), hi = min(off + 8, ps ? 9 : 5);
            int rel = lo;
            for (; rel + 1 < hi; rel += 2) { const int key0[2] = {(rel - p0) * 64 + cst, (rel + 1 - p0) * 64 + cst}; const int dr[2] = {(r0 + rel - off) - r + 7, (r0 + rel + 1 - off) - r + 7};
                na_step<2>(lds, NB_KLOC, NB_VLOC, 656, key0, true, dr, rpb, qf, fr, fq, lane, cst, cq, c0w, m_run, l_run, O); }
            if (rel < hi) { const int key0[1] = {(rel - p0) * 64 + cst}; const int dr[1] = {(r0 + rel - off) - r + 7};
                na_step<1>(lds, NB_KLOC, NB_VLOC, 656, key0, true, dr, rpb, qf, fr, fq, lane, cst, cq, c0w, m_run, l_run, O); }
        }
        { const int dr[4] = {0, 0, 0, 0}; const int key0[4] = {0, 32, 64, 96};
          na_step<4>(lds, NB_KCTX, NB_VCTX, 272, key0, false, dr, rpb, qf, fr, fq, lane, cst, cq, c0w, m_run, l_run, O); }
    }
#undef NA_LOAD
    l_run = xsum16(l_run); l_run = xsum32(l_run);
    const float inv = 1.0f / l_run;
#pragma unroll
    for (int d = 0; d < 4; ++d) { u32x2 w; w.x = pk_bf16(O[d][0] * inv, O[d][1] * inv); w.y = pk_bf16(O[d][2] * inv, O[d][3] * inv);
        *(u32x2*)(Y + (size_t)qrow * 1024 + 256 + h * 64 + d * 16 + fq * 4) = w; }
}

constexpr int GL_GT = 0, GL_G = 13824, GL_Q = 39424, GL_K = 57856, GL_VT = 76288, GL_X = 90112, GL_ST = 108544;
__device__ __forceinline__ int gla_row0(int b, int n) { return n < 32 ? b * 2048 + n * 64 : MLAT + b * 256 + (n - 32) * 64; }
struct PrepRegs { u32x4 ga[3]; u32x4 bw[3]; float bias[3]; };
__device__ __forceinline__ void gla_prep_load(PrepRegs& R, const Params& p, int l, int h, int row0, int wave, int fr, int fq) {
    const bf16_t* Z = (const bf16_t*)(p.ws + OFF_Z);
#pragma unroll
    for (int q = 0; q < 3; ++q) { const int tile = wave * 3 + q, mi = tile / 6, ni = tile % 6, dir = ni / 3, c = (ni % 3) * 16 + fr;
        R.ga[q] = *(const u32x4*)(Z + (size_t)(row0 + mi * 16 + fr) * ZLD + ZC_GA + fq * 8);
        R.bw[q] = (u32x4){0u, 0u, 0u, 0u};
        if ((fq >> 1) == dir) { const float* aw = p.gla_alpha_w + ((size_t)(l * 2 + dir) * 16 + (fq & 1) * 8) * 192 + h * 48 + c; float w[8];
#pragma unroll
            for (int e = 0; e < 8; ++e) w[e] = aw[e * 192];
            R.bw[q].x = pk_bf16(w[0], w[1]); R.bw[q].y = pk_bf16(w[2], w[3]); R.bw[q].z = pk_bf16(w[4], w[5]); R.bw[q].w = pk_bf16(w[6], w[7]); }
        R.bias[q] = p.gla_alpha_b[(size_t)(l * 2 + dir) * 192 + h * 48 + c]; }
}
__device__ __forceinline__ void gla_prep(const PrepRegs& R, LAS unsigned char* lds, int wave, int fr, int fq) {
    LAS float* G = (LAS float*)(lds + GL_G);
    __syncthreads();
#pragma unroll
    for (int q = 0; q < 3; ++q) { const int tile = wave * 3 + q, mi = tile / 6, ni = tile % 6, dir = ni / 3, c = (ni % 3) * 16 + fr;
        const f32x4 acc = mfma16(as_bf8(R.ga[q]), as_bf8(R.bw[q]), (f32x4){0.f, 0.f, 0.f, 0.f});
        float g[4];
#pragma unroll
        for (int i = 0; i < 4; ++i) { const float sv = acc[i] + R.bias[q]; g[i] = (fminf(sv, 0.f) - __logf(1.f + __expf(-fabsf(sv)))) * (1.0f / 16.0f); }
        u32x2 w2; w2.x = pk_bf16(g[0], g[1]); w2.y = pk_bf16(g[2], g[3]);
        *(LAS u32x2*)(lds + GL_GT + (dir * 48 + c) * 144 + (mi * 16 + fq * 4) * 2) = w2; }
    __syncthreads();
#pragma unroll
    for (int q = 0; q < 3; ++q) { const int tile = wave * 3 + q, mi = tile / 6, ni = tile % 6, dir = ni / 3;
        f32x4 acc = (f32x4){0.f, 0.f, 0.f, 0.f};
#pragma unroll
        for (int kk = 0; kk < 2; ++kk) { const int t = mi * 16 + fr; bf16x8 tri;
#pragma unroll
            for (int e = 0; e < 8; ++e) { const int sidx = kk * 32 + fq * 8 + e; tri[e] = (dir ? (sidx >= t) : (sidx <= t)) ? (short)0x3F80 : (short)0; }
            const bf16x8 bb = *(const LAS bf16x8*)(lds + GL_GT + (ni * 16 + fr) * 144 + kk * 64 + fq * 16);
            acc = mfma16(tri, bb, acc); }
#pragma unroll
        for (int i = 0; i < 4; ++i) G[(dir * 64 + mi * 16 + fq * 4 + i) * 48 + (ni % 3) * 16 + fr] = acc[i]; }
    __syncthreads();
}
__device__ __forceinline__ void gla_g1_item(int wv, const Params& p, int l, int it, LAS unsigned char* lds) {
    const int tid = otid(wv), lane = tid & 63, wave = tid >> 6, fr = lane & 15, fq = lane >> 4;
    const int b = it / 144, rem = it % 144, n = rem >> 2, h = rem & 3;
    const int row0 = gla_row0(b, n); const bool latent = n < 32;
    const bf16_t* Z = (const bf16_t*)(p.ws + OFF_Z);
    PrepRegs R; gla_prep_load(R, p, l, h, row0, wave, fr, fq);
    const int t3 = tid / 6, r6 = tid % 6, half = r6 / 3, j4 = (r6 % 3) * 4, c1 = half * 24 + j4;
    u32x2 w1 = (u32x2){0u, 0u}, w2 = (u32x2){0u, 0u}; f32x4 ra = (f32x4){1.f, 0.f, 1.f, 0.f}, rb = ra;
    if (tid < 384) { const bf16_t* zr = Z + (size_t)(row0 + t3) * ZLD + ZC_GK + h * 48 + c1; w1 = *(const u32x2*)zr; w2 = *(const u32x2*)(zr + 12);
        if (latent) { const float* rp = (const float*)(p.ws + OFF_ROPE) + ((half ? t3 : n) * 12 + j4) * 2; ra = *(const f32x4*)rp; rb = *(const f32x4*)(rp + 4); } }
    const bf16_t* vsrc = latent ? (const bf16_t*)(p.ws + OFF_TLAT) + ((size_t)(b * 1024 + TC_GV + h * 96)) * 2048 + n * 64
                                : (const bf16_t*)(p.ws + OFF_TCTX) + ((size_t)(b * 1024 + TC_GV + h * 96)) * 256 + (n - 32) * 64;
    const int vld = latent ? 2048 : 256;
    u32x4 vw[2];
#pragma unroll
    for (int i = 0; i < 2; ++i) { const int e = tid + i * 512; vw[i] = (e < 768) ? *(const u32x4*)(vsrc + (size_t)(e >> 3) * vld + (e & 7) * 8) : (u32x4){0u, 0u, 0u, 0u}; }
    gla_prep(R, lds, wave, fr, fq);
    LAS float* G = (LAS float*)(lds + GL_G);
    if (tid < 384) { const int t = t3;
        float x1[4] = {bflo(w1.x), bfhi(w1.x), bflo(w1.y), bfhi(w1.y)}, x2[4] = {bflo(w2.x), bfhi(w2.x), bflo(w2.y), bfhi(w2.y)};
        { const float cn[4] = {ra[0], ra[2], rb[0], rb[2]}, sn[4] = {ra[1], ra[3], rb[1], rb[3]};
#pragma unroll
            for (int e = 0; e < 4; ++e) { const float a1 = x1[e], a2 = x2[e]; x1[e] = a1 * cn[e] - a2 * sn[e]; x2[e] = a2 * cn[e] + a1 * sn[e]; } }
#pragma unroll
        for (int dir = 0; dir < 2; ++dir) { const int tl = dir ? 0 : 63;
            const f32x4 b1 = *(const LAS f32x4*)(G + (dir * 64 + t) * 48 + c1), b2 = *(const LAS f32x4*)(G + (dir * 64 + t) * 48 + c1 + 12);
            const f32x4 l1 = *(const LAS f32x4*)(G + (dir * 64 + tl) * 48 + c1), l2 = *(const LAS f32x4*)(G + (dir * 64 + tl) * 48 + c1 + 12);
#pragma unroll
            for (int e = 0; e < 4; ++e) {
                *(LAS bf16_t*)(lds + GL_X + (dir * 48 + c1 + e) * 144 + t * 2) = f2bf(x1[e] * __expf(l1[e] - b1[e]));
                *(LAS bf16_t*)(lds + GL_X + (dir * 48 + c1 + 12 + e) * 144 + t * 2) = f2bf(x2[e] * __expf(l2[e] - b2[e])); } } }
#pragma unroll
    for (int i = 0; i < 2; ++i) { const int e = tid + i * 512; if (e < 768) *(LAS u32x4*)(lds + GL_VT + (e >> 3) * 144 + (e & 7) * 16) = vw[i]; }
    bf16_t* Sb = (bf16_t*)(p.ws + OFF_S); float* DEC = (float*)(p.ws + OFF_DEC);
    if (tid < 96) { const int dir = tid / 48, c = tid % 48; const size_t slot = (size_t)((b * 4 + h) * 2 + dir) * 36 + n;
        DEC[slot * 48 + c] = __expf(dir ? G[64 * 48 + c] : G[63 * 48 + c]); }
    __syncthreads();
    for (int tl = wave; tl < 36; tl += 8) { const int dir = tl / 18, r2 = tl % 18, mi = r2 / 3, ni = r2 % 3;
        f32x4 acc = (f32x4){0.f, 0.f, 0.f, 0.f};
#pragma unroll
        for (int kk = 0; kk < 2; ++kk) {
            const bf16x8 a = *(const LAS bf16x8*)(lds + GL_VT + (mi * 16 + fr) * 144 + kk * 64 + fq * 16);
            const bf16x8 bb = *(const LAS bf16x8*)(lds + GL_X + (dir * 48 + ni * 16 + fr) * 144 + kk * 64 + fq * 16);
            acc = mfma16(a, bb, acc); }
        bf16_t* dst = Sb + ((size_t)((b * 4 + h) * 2 + dir) * 36 + n) * 4608;
#pragma unroll
        for (int i = 0; i < 4; ++i) dst[(mi * 16 + fq * 4 + i) * 48 + ni * 16 + fr] = f2bf(acc[i]); }
}
__device__ __forceinline__ void gla_g3_item(int wv, const Params& p, int l, int b, int n, int h, LAS unsigned char* lds) {
    const int tid = otid(wv), lane = tid & 63, wave = tid >> 6, fr = lane & 15, fq = lane >> 4;
    const int row0 = gla_row0(b, n); const bool latent = n < 32;
    const bf16_t* Z = (const bf16_t*)(p.ws + OFF_Z);
    PrepRegs R; gla_prep_load(R, p, l, h, row0, wave, fr, fq);
    const int t3 = tid / 6, r6 = tid % 6, half = r6 / 3, j4 = (r6 % 3) * 4, c1 = half * 24 + j4;
    u32x2 q1w = (u32x2){0u, 0u}, q2w = q1w, k1w = q1w, k2w = q1w; f32x4 ra = (f32x4){1.f, 0.f, 1.f, 0.f}, rb = ra;
    if (tid < 384) { const bf16_t* zq = Z + (size_t)(row0 + t3) * ZLD + ZC_GQ + h * 48 + c1; const bf16_t* zk = Z + (size_t)(row0 + t3) * ZLD + ZC_GK + h * 48 + c1;
        q1w = *(const u32x2*)zq; q2w = *(const u32x2*)(zq + 12); k1w = *(const u32x2*)zk; k2w = *(const u32x2*)(zk + 12);
        if (latent) { const float* rp = (const float*)(p.ws + OFF_ROPE) + ((half ? t3 : n) * 12 + j4) * 2; ra = *(const f32x4*)rp; rb = *(const f32x4*)(rp + 4); } }
    const bf16_t* Sb = (const bf16_t*)(p.ws + OFF_S);
    u32x2 sw[5];
#pragma unroll
    for (int i = 0; i < 5; ++i) { const int e = tid + i * 512; if (e < 2304) { const int dir = e / 1152, idx = e % 1152, dv = idx / 12, dk = (idx % 12) * 4;
            sw[i] = *(const u32x2*)(Sb + ((size_t)((b * 4 + h) * 2 + dir) * 36 + n) * 4608 + dv * 48 + dk); } else sw[i] = (u32x2){0u, 0u}; }
    const bf16_t* vsrc = latent ? (const bf16_t*)(p.ws + OFF_TLAT) + ((size_t)(b * 1024 + TC_GV + h * 96)) * 2048 + n * 64
                                : (const bf16_t*)(p.ws + OFF_TCTX) + ((size_t)(b * 1024 + TC_GV + h * 96)) * 256 + (n - 32) * 64;
    const int vld = latent ? 2048 : 256;
    u32x4 vw[2];
#pragma unroll
    for (int i = 0; i < 2; ++i) { const int e = tid + i * 512; vw[i] = (e < 768) ? *(const u32x4*)(vsrc + (size_t)(e >> 3) * vld + (e & 7) * 8) : (u32x4){0u, 0u, 0u, 0u}; }
    const int tf = tid >> 3, part = tid & 7;
    u32x2 ggw[3];
    { const bf16_t* gp = Z + (size_t)(row0 + tf) * ZLD + ZC_GG + h * 96 + part * 12;
#pragma unroll
      for (int q4 = 0; q4 < 3; ++q4) ggw[q4] = *(const u32x2*)(gp + q4 * 4); }
    gla_prep(R, lds, wave, fr, fq);
    LAS float* G = (LAS float*)(lds + GL_G);
    if (tid < 384) { const int t = t3;
        float q1[4] = {bflo(q1w.x), bfhi(q1w.x), bflo(q1w.y), bfhi(q1w.y)}, q2[4] = {bflo(q2w.x), bfhi(q2w.x), bflo(q2w.y), bfhi(q2w.y)};
        float k1[4] = {bflo(k1w.x), bfhi(k1w.x), bflo(k1w.y), bfhi(k1w.y)}, k2[4] = {bflo(k2w.x), bfhi(k2w.x), bflo(k2w.y), bfhi(k2w.y)};
        { const float cn[4] = {ra[0], ra[2], rb[0], rb[2]}, sn[4] = {ra[1], ra[3], rb[1], rb[3]};
#pragma unroll
            for (int e = 0; e < 4; ++e) { float a1 = q1[e], a2 = q2[e]; q1[e] = a1 * cn[e] - a2 * sn[e]; q2[e] = a2 * cn[e] + a1 * sn[e];
                a1 = k1[e]; a2 = k2[e]; k1[e] = a1 * cn[e] - a2 * sn[e]; k2[e] = a2 * cn[e] + a1 * sn[e]; } }
#pragma unroll
        for (int dir = 0; dir < 2; ++dir) {
            const f32x4 b1 = *(const LAS f32x4*)(G + (dir * 64 + t) * 48 + c1), b2 = *(const LAS f32x4*)(G + (dir * 64 + t) * 48 + c1 + 12);
            float e1[4], e2[4], i1[4], i2[4];
#pragma unroll
            for (int e = 0; e < 4; ++e) { e1[e] = __expf(b1[e]); e2[e] = __expf(b2[e]); i1[e] = __expf(-b1[e]); i2[e] = __expf(-b2[e]); }
            const float qs = 0.14433756729740643f;
            u32x2 w;
            w.x = pk_bf16(q1[0] * qs * e1[0], q1[1] * qs * e1[1]); w.y = pk_bf16(q1[2] * qs * e1[2], q1[3] * qs * e1[3]); *(LAS u32x2*)(lds + GL_Q + (dir * 64 + t) * 144 + c1 * 2) = w;
            w.x = pk_bf16(q2[0] * qs * e2[0], q2[1] * qs * e2[1]); w.y = pk_bf16(q2[2] * qs * e2[2], q2[3] * qs * e2[3]); *(LAS u32x2*)(lds + GL_Q + (dir * 64 + t) * 144 + (c1 + 12) * 2) = w;
            w.x = pk_bf16(k1[0] * i1[0], k1[1] * i1[1]); w.y = pk_bf16(k1[2] * i1[2], k1[3] * i1[3]); *(LAS u32x2*)(lds + GL_K + (dir * 64 + t) * 144 + c1 * 2) = w;
            w.x = pk_bf16(k2[0] * i2[0], k2[1] * i2[1]); w.y = pk_bf16(k2[2] * i2[2], k2[3] * i2[3]); *(LAS u32x2*)(lds + GL_K + (dir * 64 + t) * 144 + (c1 + 12) * 2) = w; } }
    for (int e = tid; e < 2048; e += 512) { const int rw = e >> 4, c = 48 + (e & 15);
        *(LAS bf16_t*)(lds + GL_Q + rw * 144 + c * 2) = 0; *(LAS bf16_t*)(lds + GL_K + rw * 144 + c * 2) = 0; }
#pragma unroll
    for (int i = 0; i < 5; ++i) { const int e = tid + i * 512; if (e < 2304) { const int dir = e / 1152, idx = e % 1152, dv = idx / 12, dk = (idx % 12) * 4;
            *(LAS u32x2*)(lds + GL_ST + (dir * 96 + dv) * 144 + dk * 2) = sw[i]; } }
    for (int e = tid; e < 3072; e += 512) { const int rw = e >> 4, c = 48 + (e & 15); *(LAS bf16_t*)(lds + GL_ST + rw * 144 + c * 2) = 0; }
#pragma unroll
    for (int i = 0; i < 2; ++i) { const int e = tid + i * 512; if (e < 768) *(LAS u32x4*)(lds + GL_VT + (e >> 3) * 144 + (e & 7) * 16) = vw[i]; }
    __syncthreads();
    { const int dir = wave >> 2, mi = wave & 3;
      bf16x8 a[2];
#pragma unroll
      for (int kk = 0; kk < 2; ++kk) a[kk] = *(const LAS bf16x8*)(lds + GL_Q + (dir * 64 + mi * 16 + fr) * 144 + kk * 64 + fq * 16);
#pragma unroll
      for (int ni = 0; ni < 4; ++ni) { f32x4 acc = (f32x4){0.f, 0.f, 0.f, 0.f};
#pragma unroll
          for (int kk = 0; kk < 2; ++kk) { const bf16x8 bb = *(const LAS bf16x8*)(lds + GL_K + (dir * 64 + ni * 16 + fr) * 144 + kk * 64 + fq * 16); acc = mfma16(a[kk], bb, acc); }
#pragma unroll
          for (int i = 0; i < 4; ++i) { const int t = mi * 16 + fq * 4 + i, sidx = ni * 16 + fr; const bool keep = dir ? (sidx >= t) : (sidx <= t);
              *(LAS bf16_t*)(lds + GL_X + (dir * 64 + t) * 144 + sidx * 2) = f2bf(keep ? acc[i] : 0.f); } } }
    __syncthreads();
    LAS float* Ob = (LAS float*)lds;
    { const int mi = wave >> 1, nb = (wave & 1) * 3;
#pragma unroll
      for (int nn = 0; nn < 3; ++nn) { const int ni = nb + nn; f32x4 acc = (f32x4){0.f, 0.f, 0.f, 0.f};
#pragma unroll
          for (int dir = 0; dir < 2; ++dir)
#pragma unroll
              for (int kk = 0; kk < 2; ++kk) {
                  const bf16x8 a1 = *(const LAS bf16x8*)(lds + GL_X + (dir * 64 + mi * 16 + fr) * 144 + kk * 64 + fq * 16);
                  const bf16x8 b1 = *(const LAS bf16x8*)(lds + GL_VT + (ni * 16 + fr) * 144 + kk * 64 + fq * 16);
                  acc = mfma16(a1, b1, acc);
                  const bf16x8 a2 = *(const LAS bf16x8*)(lds + GL_Q + (dir * 64 + mi * 16 + fr) * 144 + kk * 64 + fq * 16);
                  const bf16x8 b2 = *(const LAS bf16x8*)(lds + GL_ST + (dir * 96 + ni * 16 + fr) * 144 + kk * 64 + fq * 16);
                  acc = mfma16(a2, b2, acc); }
#pragma unroll
          for (int i = 0; i < 4; ++i) Ob[(mi * 16 + fq * 4 + i) * 97 + ni * 16 + fr] = acc[i]; } }
    __syncthreads();
    { const int t = tf; float o[12]; float ss = 0.f;
#pragma unroll
      for (int e = 0; e < 12; ++e) { o[e] = Ob[t * 97 + part * 12 + e]; ss += o[e] * o[e]; }
      ss += shx(ss, 1, lane); ss += shx(ss, 2, lane); ss += shx(ss, 4, lane);
      const float rs = rsqrtf(ss * (1.0f / 96.0f) + 1e-6f);
      const float* gn = p.gla_o_norm + l * 96 + part * 12;
      bf16_t* yp = (bf16_t*)(p.ws + OFF_HY) + (size_t)(row0 + t) * 1024 + 640 + h * 96 + part * 12;
#pragma unroll
      for (int q4 = 0; q4 < 3; ++q4) { const u32x2 gw = ggw[q4]; float g[4] = {bflo(gw.x), bfhi(gw.x), bflo(gw.y), bfhi(gw.y)}; float r[4];
#pragma unroll
          for (int e = 0; e < 4; ++e) r[e] = o[q4 * 4 + e] * rs * gn[q4 * 4 + e] * (g[e] * __builtin_amdgcn_rcpf(1.f + __expf(-g[e])));
          u32x2 w; w.x = pk_bf16(r[0], r[1]); w.y = pk_bf16(r[2], r[3]); *(u32x2*)(yp + q4 * 4) = w; } }
}
__device__ __forceinline__ void gla_scan(int wv, const Params& p) {
    bf16_t* S = (bf16_t*)(p.ws + OFF_S); const float* DEC = (const float*)(p.ws + OFF_DEC);
    for (int e = blockIdx.x * 512 + otid(wv); e < 147456; e += gridDim.x * 512) {
        const int chain = e / 2304, idx = (e % 2304) * 2, dk = idx % 48, dir = chain & 1; const size_t base = (size_t)chain * 36;
        float s0 = 0.f, s1 = 0.f;
        for (int st0 = 0; st0 < 36; st0 += 6) { unsigned v[6]; float d0[6], d1[6]; unsigned* sp[6];
#pragma unroll
            for (int u = 0; u < 6; ++u) { const int st = st0 + u, n = dir ? 35 - st : (st < 4 ? 32 + st : st - 4); sp[u] = (unsigned*)(S + (base + n) * 4608 + idx); v[u] = *sp[u];
                const float* dp = DEC + (base + n) * 48 + dk; d0[u] = dp[0]; d1[u] = dp[1]; }
#pragma unroll
            for (int u = 0; u < 6; ++u) { *sp[u] = pk_bf16(s0, s1); s0 = s0 * d0[u] + bflo(v[u]); s1 = s1 * d1[u] + bfhi(v[u]); } }
    }
}

#define XB_TMO      128
#define XB_XCNT(j)  (256  + 64 * (j))
#define XB_XSUB(j)  (1280 + 64 * (j))
#define XB_XGEN(j)  (2304 + 64 * (j))
#define XB_TOP      3328
#define XB_TOPGEN   3392
#define XB_SPIN_CAP (1u << 22)
__device__ __forceinline__ unsigned xb_ld(unsigned* p)              { return __hip_atomic_load(p, __ATOMIC_RELAXED, __HIP_MEMORY_SCOPE_AGENT); }
__device__ __forceinline__ unsigned xb_add(unsigned* p, unsigned v) { return __hip_atomic_fetch_add(p, v, __ATOMIC_RELAXED, __HIP_MEMORY_SCOPE_AGENT); }
__device__ __forceinline__ unsigned xb_xcc_id() { return (unsigned)__builtin_amdgcn_s_getreg((3 << 11) | 20) & 0xFu; }
#define XB_SPIN(cond, bar) do { unsigned _sp = 0; while (cond) { __builtin_amdgcn_s_sleep(1); \
    if ((++_sp & 255u) == 0u) { if (xb_ld(&(bar)[XB_TMO])) break; if (_sp > XB_SPIN_CAP) { atomicAdd(&(bar)[XB_TMO], 1u); break; } } } } while (0)
__device__ __forceinline__ void xcd_barrier_complete(unsigned* bar, unsigned x, unsigned& nloc, unsigned& nx) {
    const unsigned G = gridDim.x;
    unsigned sum, cnt, mine, sp = 0u;
    for (;;) {
        sum = 0u; cnt = 0u; mine = 0u;
#pragma unroll
        for (unsigned j = 0; j < 16; ++j) { const unsigned c = xb_ld(&bar[XB_XCNT(j)]); sum += c; cnt += (c > 0u) ? 1u : 0u; mine = (j == x) ? c : mine; }
        if (sum == G) break;
        __builtin_amdgcn_s_sleep(1);
        if ((++sp & 255u) == 0u) { if (xb_ld(&bar[XB_TMO])) break; if (sp > XB_SPIN_CAP) { atomicAdd(&bar[XB_TMO], 1u); break; } }
    }
    nloc = mine > 0u ? mine : 1u; nx = cnt > 0u ? cnt : 1u;
}
__device__ __forceinline__ void grid_bar(int wv, unsigned* bar, volatile LAS unsigned* st) {
    asm volatile("s_waitcnt vmcnt(0)" ::: "memory");
    __syncthreads();
    if (otid(wv) == 0) {
        __builtin_amdgcn_s_waitcnt(0);
        const unsigned x = xb_xcc_id();
        unsigned nloc = st[0], nx = st[1];
        if (nloc == 0u) { xcd_barrier_complete(bar, x, nloc, nx); st[0] = nloc; st[1] = nx; }
        const unsigned old = xb_add(&bar[XB_XSUB(x)], 1u);
        const unsigned gen = old / nloc;
        if (old + 1u == (gen + 1u) * nloc) {
            __builtin_amdgcn_fence(__ATOMIC_RELEASE, "agent");
            asm volatile("s_waitcnt vmcnt(0)" ::: "memory");
            const unsigned og = xb_add(&bar[XB_TOP], 1u);
            const unsigned tg = og / nx;
            if (og + 1u == (tg + 1u) * nx) xb_add(&bar[XB_TOPGEN], 1u);
            else XB_SPIN(xb_ld(&bar[XB_TOPGEN]) == tg, bar);
            __builtin_amdgcn_fence(__ATOMIC_ACQUIRE, "agent");
            xb_add(&bar[XB_XGEN(x)], 1u);
            asm volatile("s_waitcnt vmcnt(0)" ::: "memory");
        } else {
            XB_SPIN(xb_ld(&bar[XB_XGEN(x)]) == gen, bar);
            __builtin_amdgcn_fence(__ATOMIC_ACQUIRE, "agent");
            asm volatile("s_waitcnt vmcnt(0)" ::: "memory");
        }
    }
    __syncthreads();
}

__global__ void __launch_bounds__(512, 2) hybrid_fwd(Params p_unused) {
    extern __shared__ __attribute__((aligned(16))) unsigned char smem[];
    LAS unsigned char* lds = (LAS unsigned char*)smem;
    const int wv = __builtin_amdgcn_readfirstlane((int)(threadIdx.x >> 6));
    const int G = gridDim.x, c = blockIdx.x;
    { volatile LAS unsigned* st = (volatile LAS unsigned*)(lds + QWORD_OFF + 4); const Params pb = ldp();
      if (otid(wv) == 0) { st[0] = 0u; st[1] = 0u; (void)xb_add((unsigned*)(pb.ws + OFF_BAR) + XB_XCNT(xb_xcc_id()), 1u); }
      __syncthreads(); }
#define GRID_SYNC() do { const Params pb = ldp(); grid_bar(wv, (unsigned*)(pb.ws + OFF_BAR), (volatile LAS unsigned*)(lds + QWORD_OFF + 4)); } while (0)

#ifndef PHM
#define PHM 0xFFFF
#endif
    if (PHM & 1) { const Params p = ldp(); phase0(wv, p, lds, c, G, 0, G == 256 ? 96 : 192, true); }
    GRID_SYNC();
#pragma nounroll
    for (int l = 0; l < 2; ++l) {
        const bool need_ctx = (l == 0);
        const int nM = need_ctx ? 72 : 64;
        if (PHM & 2) { const Params p = ldp(); phase_norm(wv, p, l, 0, MALL, l == 0 ? 0 : 5, (const float*)(p.ws + OFF_MOD) + (size_t)8 * 6144 + 5120); }
        { const Params p = ldp(); phase_weights(wv, p, l, lds, c, G); }
        GRID_SYNC();
        if (PHM & 8) { const Params p = ldp(); SchedInproj S{{need_ctx ? 792 : 768, G, c}, p.ws, need_ctx ? 0 : 1, (size_t)0 * WSET}; g8::EpiBf E; g8::gemm_phase(wv, lds, 1024, S, E); }
        if (l == 0) {
            const Params p = ldp(); if (G == 256) { if (c >= 48) trig_tables(wv, p, lds, c - 48, 208); } else trig_tables(wv, p, lds, c, G); }
        GRID_SYNC();
        { const Params p = ldp(); fourier_mid_row(wv, p); }
        if (PHM & 16) { const Params p = ldp(); SchedF1Lat S{{64, G, c}, p.ws}; g8::EpiBf E; g8::gemm_phase(wv, lds, 2048, S, E); }
        if ((PHM & 16) && need_ctx) { const Params p = ldp(); SchedF1Ctx S{{16, G, G - 1 - c}, p.ws}; g8::EpiBf E; g8::gemm_phase(wv, lds, 256, S, E); }
        { const int nNA = need_ctx ? 864 : 768, total = nNA + 1152;
          unsigned nxt_it = 0;
          const bool t0 = (otid(wv) == 0);
          if (t0) { const Params p = ldp(); nxt_it = atomicAdd((unsigned*)(p.ws + OFF_CTR) + l, 1u); }
          for (;;) {
              __syncthreads();
              if (t0) *(LAS unsigned*)(lds + QWORD_OFF) = nxt_it;
              __syncthreads();
              const int it = (int)*(LAS unsigned*)(lds + QWORD_OFF);
              if (it >= total) break;
              if (t0) { const Params p = ldp(); nxt_it = atomicAdd((unsigned*)(p.ws + OFF_CTR) + l, 1u); }
              if (it < nNA) { if (PHM & 32) { const Params p = ldp(); na_item(wv, p, l, it, lds); } } else { if (PHM & 64) { const Params p = ldp(); gla_g1_item(wv, p, l, it - nNA, lds); } }
          } }
        GRID_SYNC();
        if (PHM & 256) { const Params p = ldp(); gla_scan(wv, p); }
        GRID_SYNC();
        if (PHM & 128) { const Params p = ldp(); SchedF2 S{{nM, G, c}, p.ws, (size_t)0 * WSET}; g8::EpiBf E; g8::gemm_phase(wv, lds, 512, S, E); }
        { const int nch = need_ctx ? 36 : 32, nit = 8 * nch * 4;
          unsigned nxt_it = 0; const bool t0 = (otid(wv) == 0);
          if (t0) { const Params p = ldp(); nxt_it = atomicAdd((unsigned*)(p.ws + OFF_CTR) + 2 + l, 1u); }
          for (;;) {
              __syncthreads();
              if (t0) *(LAS unsigned*)(lds + QWORD_OFF) = nxt_it;
              __syncthreads();
              const int it = (int)*(LAS unsigned*)(lds + QWORD_OFF);
              if (it >= nit) break;
              if (t0) { const Params p = ldp(); nxt_it = atomicAdd((unsigned*)(p.ws + OFF_CTR) + 2 + l, 1u); }
              const int b = it / (nch * 4), rem = it % (nch * 4);
              if (PHM & 512) { const Params p = ldp(); gla_g3_item(wv, p, l, b, rem >> 2, rem & 3, lds); }
          } }
        GRID_SYNC();
        if (PHM & 1024) { const Params p = ldp(); const float* mod = (const float*)(p.ws + OFF_MOD); SchedRes S{G, c, need_ctx ? 1 : 0, 4, 16, 4, p.ws, (const char*)(p.ws + OFF_HY), (size_t)256 * 2048, (const char*)(p.ws + OFF_WOUT + (size_t)0 * WSET), (size_t)256 * 2048,
                     l == 0 ? (const void*)p.x : (const void*)(p.ws + OFF_XB), (void*)(p.ws + OFF_XB), l == 0 ? 2 : 3, mod + (size_t)l * 9 * 6144 + 2048};
          g8::EpiRes E; g8::gemm_phase(wv, lds, 1024, S, E); }
        GRID_SYNC();
        if (PHM & 2048) { const Params p = ldp(); phase_norm(wv, p, l, 1, nM * 256, 4, (const float*)(p.ws + OFF_MOD) + (size_t)(l * 9 + 8) * 6144 + 2048); }
        GRID_SYNC();
        if (PHM & 4096) { const Params p = ldp(); SchedFfn1 S{{nM * 22, G, c}, p.ws, (size_t)0 * WSET}; g8::EpiSwiglu E; g8::gemm_phase(wv, lds, 1024, S, E); }
        if (l == 0 && G == 256 && c >= 96) { const Params p = ldp(); phase0(wv, p, lds, c - 96, 160, 96, 192, false); }
        GRID_SYNC();
        if (PHM & 8192) { const Params p = ldp(); const float* mod = (const float*)(p.ws + OFF_MOD); SchedRes S{G, c, need_ctx ? 1 : 0, 5, 44, 8, p.ws, (const char*)(p.ws + OFF_U), (size_t)256 * DFF * 2, (const char*)(p.ws + OFF_W2 + (size_t)0 * WSET), (size_t)256 * DFF * 2,
                     (const void*)(p.ws + OFF_XB), l == 0 ? (void*)(p.ws + OFF_XB) : (void*)p.out, l == 0 ? 3 : 1, mod + (size_t)l * 9 * 6144 + 5120};
          g8::EpiRes E; g8::gemm_phase(wv, lds, DFF, S, E); }
        if (l == 0) GRID_SYNC();
    }
}

extern "C" void kernel_launch(void* const* d_in, const int* in_sizes, int n_in, void* d_out, int out_size, void* d_ws, size_t ws_size, hipStream_t stream) {
    static int grid_blocks = 0;
    if (!grid_blocks) {
        int dev = 0, cus = 0, per_cu = 0;
        (void)hipGetDevice(&dev);
        (void)hipDeviceGetAttribute(&cus, hipDeviceAttributeMultiprocessorCount, dev);
        if (hipFuncSetAttribute((const void*)hybrid_fwd, hipFuncAttributeMaxDynamicSharedMemorySize, LDS_BYTES) != hipSuccess) fprintf(stderr, "hipFuncSetAttribute failed\n");
        if (hipOccupancyMaxActiveBlocksPerMultiprocessor(&per_cu, (const void*)hybrid_fwd, 512, LDS_BYTES) != hipSuccess || per_cu < 1) { fprintf(stderr, "occupancy query: %d\n", per_cu); }
        (void)hipGetLastError();
        grid_blocks = cus > 0 ? cus : 256;
        if (ws_size < WS_END) fprintf(stderr, "workspace too small: %zu < %zu\n", ws_size, (size_t)WS_END);
    }
    Params p{};
    const float** f = (const float**)&p;
    for (int i = 0; i < 20; ++i) f[i] = (const float*)d_in[i];
    p.out = (float*)d_out; p.ws = (unsigned char*)d_ws;
    (void)hipMemsetAsync((unsigned char*)d_ws + OFF_CTR, 0, 256 + 13824, stream);
    void* args[] = {&p};
    hipError_t e = hipLaunchCooperativeKernel((void*)hybrid_fwd, dim3(grid_blocks), dim3(512), args, LDS_BYTES, stream);
    if (e != hipSuccess) fprintf(stderr, "cooperative launch failed: %s (grid %d)\n", hipGetErrorString(e), grid_blocks);
}
```

```cpp
#include <hip/hip_runtime.h>
#include <hip/hip_cooperative_groups.h>
#include <cstdio>
namespace cg = cooperative_groups;

#define LAS __attribute__((address_space(3)))
typedef unsigned short bf16_t;
typedef short bf16x8 __attribute__((ext_vector_type(8)));
typedef float f32x4 __attribute__((ext_vector_type(4)));
typedef unsigned u32x4 __attribute__((ext_vector_type(4)));
typedef unsigned u32x2 __attribute__((ext_vector_type(2)));

constexpr int DM = 1024, MLAT = 16384, MALL = 18432, DFF = 2816, NINW = 2592;
constexpr int ZLD = 1568;
constexpr int ZC_NK = 384, ZC_GQ = 768, ZC_GK = 960, ZC_GG = 1152, ZC_GA = 1536;
constexpr int TC_NV = 256, TC_GV = 640;
constexpr float LOG2E = 1.4426950408889634f;
constexpr int LDS_BYTES = 147456;
constexpr int QWORD_OFF = LDS_BYTES - 16;

constexpr size_t OFF_XCTX = 0;
constexpr size_t OFF_HY   = OFF_XCTX + (size_t)2048 * 1024 * 4;
constexpr size_t OFF_Z    = OFF_HY + (size_t)MALL * 1024 * 2;
constexpr size_t OFF_TLAT = OFF_Z + (size_t)MALL * ZLD * 2;
constexpr size_t OFF_TCTX = OFF_TLAT + (size_t)8 * 1024 * 2048 * 2;
constexpr size_t OFF_PQ   = OFF_TCTX + (size_t)8 * 1024 * 256 * 2;
constexpr size_t OFF_S    = OFF_PQ + (size_t)MALL * 512 * 2;
constexpr size_t OFF_U    = OFF_Z;
static_assert((size_t)MALL * DFF * 2 <= OFF_S - OFF_Z, "U alias");
constexpr size_t OFF_DEC  = OFF_S + (size_t)2304 * 4608 * 2;
constexpr size_t OFF_WSW  = OFF_DEC + (size_t)2304 * 48 * 4;
constexpr size_t OFF_WZ   = OFF_WSW + (size_t)1024 * 1024 * 2;
constexpr size_t OFF_W13  = OFF_WZ + (size_t)1792 * 1024 * 2;
constexpr size_t OFF_WOUT = OFF_W13 + (size_t)5632 * 1024 * 2;
constexpr size_t OFF_W2   = OFF_WOUT + (size_t)1024 * 1024 * 2;
constexpr size_t OFF_WF   = OFF_W2 + (size_t)1024 * 2816 * 2;
constexpr size_t WSET     = OFF_WF + (size_t)256 * 512 * 2 - OFF_WSW;
constexpr size_t OFF_XB   = OFF_WSW + WSET;
constexpr size_t OFF_TL   = OFF_XB + (size_t)MALL * 1024 * 2;
constexpr size_t OFF_TC   = OFF_TL + (size_t)4096 * 2048 * 2;
constexpr size_t OFF_MOD  = OFF_TC + (size_t)512 * 256 * 2;
constexpr size_t OFF_ROPE = OFF_MOD + (size_t)2 * 9 * 6144 * 4;
constexpr size_t OFF_CTR  = OFF_ROPE + 64 * 12 * 8;
constexpr size_t OFF_BAR  = OFF_CTR + 256;
constexpr size_t WS_END   = OFF_BAR + 13824;
static_assert(WS_END <= (size_t)256 * 1024 * 1024, "workspace");

struct Params {
    const float *x, *c, *ctx, *c_ctx, *ada_w, *ada_b, *norm_mix, *norm_ffn, *w_in, *fnet_w, *na_q_norm, *na_k_norm, *na_rpb,
        *gla_alpha_w, *gla_alpha_b, *gla_o_norm, *w_out, *ffn_w1, *ffn_w3, *ffn_w2;
    float* out; unsigned char* ws;
};
__device__ __forceinline__ Params ldp() {
#if defined(__HIP_DEVICE_COMPILE__)
    typedef const __attribute__((address_space(4))) unsigned long long* kptr;
    kptr kp = (kptr)__builtin_amdgcn_kernarg_segment_ptr(); asm volatile("" : "+s"(kp));
    Params r; unsigned long long* d = (unsigned long long*)&r;
#pragma unroll
    for (int i = 0; i < 22; ++i) d[i] = (unsigned long long)(float*)(__attribute__((address_space(1))) float*)kp[i];
    return r;
#else
    return Params{};
#endif
}

__device__ __forceinline__ unsigned pk_bf16(float lo, float hi) { unsigned r; asm volatile("v_cvt_pk_bf16_f32 %0, %1, %2" : "=v"(r) : "v"(lo), "v"(hi)); return r; }
__device__ __forceinline__ bf16_t f2bf(float f) { unsigned u = __float_as_uint(f); u += 0x7FFFu + ((u >> 16) & 1u); return (bf16_t)(u >> 16); }
__device__ __forceinline__ float bf2f(bf16_t h) { return __uint_as_float(((unsigned)h) << 16); }
__device__ __forceinline__ float bflo(unsigned w) { return __uint_as_float(w << 16); }
__device__ __forceinline__ float bfhi(unsigned w) { return __uint_as_float(w & 0xffff0000u); }
__device__ __forceinline__ f32x4 mfma16(bf16x8 a, bf16x8 b, f32x4 c) { return __builtin_amdgcn_mfma_f32_16x16x32_bf16(a, b, c, 0, 0, 0); }
__device__ __forceinline__ bf16x8 as_bf8(u32x4 w) { return __builtin_bit_cast(bf16x8, w); }
__device__ __forceinline__ void st16_wt(void* p, u32x4 v) { *(u32x4*)p = v; }
__device__ __forceinline__ int otid(int wv) { int ln; asm volatile("v_mbcnt_lo_u32_b32 %0, -1, 0\n\tv_mbcnt_hi_u32_b32 %0, -1, %0" : "=v"(ln)); return wv * 64 + ln; }
__device__ __forceinline__ float shx(float v, int m, int lane) { return __int_as_float(__builtin_amdgcn_ds_bpermute((lane ^ m) << 2, __float_as_int(v))); }

__device__ __forceinline__ float xmax16(float v) { const auto r = __builtin_amdgcn_permlane16_swap(__float_as_uint(v), __float_as_uint(v), false, false); return fmaxf(__uint_as_float(r[0]), __uint_as_float(r[1])); }
__device__ __forceinline__ float xmax32(float v) { const auto r = __builtin_amdgcn_permlane32_swap(__float_as_uint(v), __float_as_uint(v), false, false); return fmaxf(__uint_as_float(r[0]), __uint_as_float(r[1])); }
__device__ __forceinline__ float xsum16(float v) { const auto r = __builtin_amdgcn_permlane16_swap(__float_as_uint(v), __float_as_uint(v), false, false); return __uint_as_float(r[0]) + __uint_as_float(r[1]); }
__device__ __forceinline__ float xsum32(float v) { const auto r = __builtin_amdgcn_permlane32_swap(__float_as_uint(v), __float_as_uint(v), false, false); return __uint_as_float(r[0]) + __uint_as_float(r[1]); }

namespace g8 {
constexpr int BM = 256, BK = 64, HALF = 128, HTB = HALF * BK * 2;
__device__ __forceinline__ int lds_byte(int r, int c) { const int st = (r >> 4) * 2 + (c >> 5), rr = r & 15, cc = c & 31, ob = rr * 64 + cc * 2; return st * 1024 + (ob ^ (((ob >> 9) & 1) << 5)); }
__device__ __forceinline__ void stage_rc(int b, int& R, int& C) { const int st = b / 1024, sb = b % 1024, swz = sb ^ (((sb >> 9) & 1) << 5); R = (st >> 1) * 16 + swz / 64; C = (st & 1) * 32 + (swz % 64) / 2; }
__device__ __forceinline__ int perm32(int rho) { const int n = rho >> 4, i = rho & 15; return 8 * (i >> 2) + 4 * n + (i & 3); }

struct Unit { const char* a; const char* b; char* o; const float* p1; const float* p2; int ldo; int cmax; int nt; int mode; int half; int mk; int mneg; };

struct ListOrder {
    int n, G, c;
    __device__ __forceinline__ bool idx(int i, int& Lp) const {
        const long L = (long)i * G + c; if (L >= n) return false;
        const int w = (int)L, q = n / 8, r = n % 8, xcd = w % 8, off = w / 8;
        Lp = (xcd < r ? xcd * (q + 1) : r * (q + 1) + (xcd - r) * q) + off; return true;
    }
};

struct ListOrderH {
    int n, G, c;
    __device__ __forceinline__ bool idx(int i, int& Lp, int& half) const {
        const int R = n / G, T = n % G; long L; half = 0;
        if (i == R && T > 0 && 2 * T <= G) { if (c >= 2 * T) return false; L = (long)R * G + (c >> 1); half = 1 + (c & 1); }
        else { L = (long)i * G + c; if (L >= n) return false; }
        const int w = (int)L, q = n / 8, r = n % 8, xcd = w % 8, off = w / 8;
        Lp = (xcd < r ? xcd * (q + 1) : r * (q + 1) + (xcd - r) * q) + off; return true;
    }
};

template <class Epi, class Sched>
__device__ __forceinline__ void gemm_phase(int wv, LAS unsigned char* lds, const int K, const Sched& S, const Epi& E) {
    const int tid = otid(wv), wid = __builtin_amdgcn_readfirstlane(tid >> 6), lane = tid & 63, wr = wid >> 2, wc = wid & 3, fr = lane & 15, fq = lane >> 4;
    unsigned voffA[2], voffB[2];
#pragma unroll
    for (int i = 0; i < 2; ++i) { int R, C; stage_rc(tid * 16 + i * 8192, R, C); const int Rb = Epi::PERM ? ((R & ~31) + perm32(R & 31)) : R;
        voffA[i] = (unsigned)(R * K + C) * 2u; voffB[i] = (unsigned)(Rb * K + C) * 2u; }
    const size_t kstep = (size_t)(BK * 2);
    const size_t hstep = (size_t)HALF * K * 2;
    const unsigned ldsw = (unsigned)wid * 1024u;
    const int aoff = lds_byte(wr * 64 + fr, fq * 8), boff = lds_byte(wc * 32 + fr, fq * 8);
#define G8_SA(b, h) (((b) * 2 + (h)) * HTB)
#define G8_SB(b, h) ((4 + (b) * 2 + (h)) * HTB)
#define G8_STAGE(bufoff, gbase, voff) do { _Pragma("unroll") for (int _i = 0; _i < 2; ++_i) \
        __builtin_amdgcn_global_load_lds((const unsigned*)((const char*)(gbase) + (voff)[_i]), (LAS unsigned*)(lds + (bufoff) + ldsw + _i * 8192), 16, 0, 0); } while (0)
#define G8_LDA(dst, b, h) do { _Pragma("unroll") for (int m = 0; m < 4; ++m) _Pragma("unroll") for (int k = 0; k < 2; ++k) dst[m][k] = *(const LAS bf16x8*)(lds + G8_SA(b, h) + aoff + m * 2048 + k * 1024); } while (0)
#define G8_LDB(dst, b, h) do { _Pragma("unroll") for (int n = 0; n < 2; ++n) _Pragma("unroll") for (int k = 0; k < 2; ++k) dst[n][k] = *(const LAS bf16x8*)(lds + G8_SB(b, h) + boff + n * 2048 + k * 1024); } while (0)
#define G8_MMA(ai, bj, At, Bt) do { __builtin_amdgcn_s_setprio(1); _Pragma("unroll") for (int m = 0; m < 4; ++m) _Pragma("unroll") for (int n = 0; n < 2; ++n) _Pragma("unroll") for (int k = 0; k < 2; ++k) \
        acc[ai][bj][m][n] = __builtin_amdgcn_mfma_f32_16x16x32_bf16(Bt[n][k], At[m][k], acc[ai][bj][m][n], 0, 0, 0); __builtin_amdgcn_s_setprio(0); } while (0)
#define G8_WAIT_V(n) asm volatile("s_waitcnt vmcnt(" #n ")" ::: "memory")
#define G8_WAIT_L(n) asm volatile("s_waitcnt lgkmcnt(" #n ")" ::: "memory")
#define G8_BAR __builtin_amdgcn_s_barrier()
#define G8_SCHED __builtin_amdgcn_sched_barrier(0)
    Unit cur, nxt; int ui = 0;
    if (!S.next(0, cur)) return;
    f32x4 acc[2][2][4][2];
#pragma unroll
    for (int a = 0; a < 2; ++a)
#pragma unroll
        for (int b = 0; b < 2; ++b)
#pragma unroll
            for (int m = 0; m < 4; ++m)
#pragma unroll
                for (int n = 0; n < 2; ++n) acc[a][b][m][n] = (f32x4){0.f, 0.f, 0.f, 0.f};
    bf16x8 At[4][2], B0[2][2], B1[2][2];
    const char* cA = cur.a; const char* cB = cur.b;
    G8_STAGE(G8_SB(0, 0), cB, voffB); G8_STAGE(G8_SA(0, 0), cA, voffA); G8_STAGE(G8_SB(0, 1), cB + hstep, voffB); G8_STAGE(G8_SA(0, 1), cA + hstep, voffA);
    if (wr == 1) G8_BAR;
    G8_WAIT_V(4); G8_BAR;
    G8_STAGE(G8_SB(1, 0), cB + kstep, voffB); G8_STAGE(G8_SA(1, 0), cA + kstep, voffA); G8_STAGE(G8_SB(1, 1), cB + hstep + kstep, voffB);
    G8_WAIT_V(6); G8_BAR;
    for (;;) {
        const bool has_next = S.next(ui + 1, nxt);
        const char* nA = has_next ? nxt.a : cA; const char* nB = has_next ? nxt.b : cB;
        const int nt = cur.nt; const bool full = (cur.half == 0);
        for (int t = 0; t < nt; t += 2) {
            const bool last = (t == nt - 2);
            const char* a1 = cA + (size_t)(t + 1) * kstep;
            const char* a2 = last ? nA : cA + (size_t)(t + 2) * kstep; const char* b2 = last ? nB : cB + (size_t)(t + 2) * kstep;
            const char* a3 = a2 + kstep; const char* b3 = b2 + kstep;
            G8_LDB(B0, 0, 0); G8_SCHED; G8_LDA(At, 0, 0); G8_STAGE(G8_SA(1, 1), a1 + hstep, voffA);
            G8_WAIT_L(8); G8_BAR; G8_WAIT_L(0); G8_MMA(0, 0, At, B0); G8_BAR; G8_SCHED;
            G8_LDB(B1, 0, 1); G8_STAGE(G8_SB(0, 0), b2, voffB);
            G8_BAR; G8_WAIT_L(0); G8_MMA(0, 1, At, B1); G8_BAR;
            if (full) G8_LDA(At, 0, 1); G8_STAGE(G8_SA(0, 0), a2, voffA);
            G8_BAR; G8_WAIT_L(0); if (full) G8_MMA(1, 0, At, B0); G8_BAR; G8_SCHED;
            G8_STAGE(G8_SB(0, 1), b2 + hstep, voffB);
            G8_WAIT_V(6); G8_BAR; if (full) G8_MMA(1, 1, At, B1); G8_BAR;
            G8_LDB(B0, 1, 0); G8_SCHED; G8_LDA(At, 1, 0); G8_STAGE(G8_SA(0, 1), a2 + hstep, voffA);
            G8_WAIT_L(8); G8_BAR; G8_WAIT_L(0); G8_MMA(0, 0, At, B0); G8_BAR; G8_SCHED;
            G8_LDB(B1, 1, 1); G8_STAGE(G8_SB(1, 0), b3, voffB);
            G8_BAR; G8_WAIT_L(0); G8_MMA(0, 1, At, B1); G8_BAR;
            if (full) G8_LDA(At, 1, 1); G8_STAGE(G8_SA(1, 0), a3, voffA);
            G8_BAR; G8_WAIT_L(0); if (full) G8_MMA(1, 0, At, B0); G8_BAR; G8_SCHED;
            G8_STAGE(G8_SB(1, 1), b3 + hstep, voffB);
            G8_WAIT_V(6); G8_BAR; if (full) G8_MMA(1, 1, At, B1); G8_BAR;
        }
        { const int t2 = otid(wv); E(acc, cur, wr, wc, t2 & 15, (t2 >> 4) & 3); }
        if (!has_next) break;
#pragma unroll
        for (int a = 0; a < 2; ++a)
#pragma unroll
            for (int b = 0; b < 2; ++b)
#pragma unroll
                for (int m = 0; m < 4; ++m)
#pragma unroll
                    for (int n = 0; n < 2; ++n) acc[a][b][m][n] = (f32x4){0.f, 0.f, 0.f, 0.f};
        cur = nxt; cA = nA; cB = nB; ++ui;
    }
    G8_WAIT_V(0);
    if (wr == 0) G8_BAR;
    G8_BAR;
#undef G8_SA
#undef G8_SB
#undef G8_STAGE
#undef G8_LDA
#undef G8_LDB
#undef G8_MMA
#undef G8_WAIT_V
#undef G8_WAIT_L
#undef G8_BAR
#undef G8_SCHED
}

struct EpiBf {
    static constexpr bool PERM = true;
    __device__ __forceinline__ void operator()(const f32x4 (&acc)[2][2][4][2], const Unit& u, int wr, int wc, int fr, int fq) const {
        const int row0 = wr * 64 + fr, col0 = wc * 32 + 8 * fq;
#pragma unroll
        for (int ai = 0; ai < 2; ++ai) if (ai == 0 || u.half == 0)
#pragma unroll
            for (int m = 0; m < 4; ++m) { const int rr = row0 + ai * HALF + m * 16; bf16_t* rowp = (bf16_t*)u.o + (size_t)rr * u.ldo + col0;
                const int k = u.mk + rr; const bool mir = (u.mk >= 0) && (k > 0);
                bf16_t* rowm = (bf16_t*)u.p1 + (size_t)(2048 - k) * u.ldo + col0;
#pragma unroll
                for (int bj = 0; bj < 2; ++bj) { if (col0 + bj * HALF < u.cmax) { const f32x4 v0 = acc[ai][bj][m][0], v1 = acc[ai][bj][m][1];
                    u32x4 w; w.x = pk_bf16(v0[0], v0[1]); w.y = pk_bf16(v0[2], v0[3]); w.z = pk_bf16(v1[0], v1[1]); w.w = pk_bf16(v1[2], v1[3]);
                    st16_wt(rowp + bj * HALF, w);
                    if (mir) { const float sg = u.mneg ? -1.f : 1.f; u32x4 w2; w2.x = pk_bf16(v0[0] * sg, v0[1] * sg); w2.y = pk_bf16(v0[2] * sg, v0[3] * sg); w2.z = pk_bf16(v1[0] * sg, v1[1] * sg); w2.w = pk_bf16(v1[2] * sg, v1[3] * sg);
                        st16_wt(rowm + bj * HALF, w2); } } } }
    }
};
struct EpiRes {
    static constexpr bool PERM = true;
    __device__ __forceinline__ void operator()(const f32x4 (&acc)[2][2][4][2], const Unit& u, int wr, int wc, int fr, int fq) const {
        const int row0 = wr * 64 + fr, col0 = wc * 32 + 8 * fq;
        if (u.mode == 0) {
            f32x4 gv[2][2];
#pragma unroll
            for (int bj = 0; bj < 2; ++bj)
#pragma unroll
                for (int n = 0; n < 2; ++n) gv[bj][n] = *(const f32x4*)(u.p2 + col0 + bj * HALF + n * 4);
            const bool bb16 = (u.cmax & 1) != 0, ob16 = (u.cmax & 2) != 0;
            f32x4 bs[2][2][2];
#define RES_LOAD(BUF, OFF) do { _Pragma("unroll") for (int bj = 0; bj < 2; ++bj) { \
                if (bb16) { const u32x4 w = *(const u32x4*)((const bf16_t*)u.p1 + (OFF) + bj * HALF); bs[BUF][bj][0] = (f32x4){bflo(w.x), bfhi(w.x), bflo(w.y), bfhi(w.y)}; bs[BUF][bj][1] = (f32x4){bflo(w.z), bfhi(w.z), bflo(w.w), bfhi(w.w)}; } \
                else { bs[BUF][bj][0] = *(const f32x4*)(u.p1 + (OFF) + bj * HALF); bs[BUF][bj][1] = *(const f32x4*)(u.p1 + (OFF) + bj * HALF + 4); } } } while (0)
            RES_LOAD(0, (size_t)row0 * 1024 + col0);
#pragma unroll
            for (int g = 0; g < 8; ++g) { const int ai = g >> 2, m = g & 3; const size_t off = (size_t)(row0 + ai * HALF + m * 16) * 1024 + col0;
                if (g < 7) { const int ai2 = (g + 1) >> 2, m2 = (g + 1) & 3; const size_t off2 = (size_t)(row0 + ai2 * HALF + m2 * 16) * 1024 + col0;
                    if (g & 1) { RES_LOAD(0, off2); } else { RES_LOAD(1, off2); } }
                asm volatile("" ::: "memory");
#pragma unroll
                for (int bj = 0; bj < 2; ++bj) { const f32x4 x0 = bs[g & 1][bj][0] + gv[bj][0] * acc[ai][bj][m][0], x1 = bs[g & 1][bj][1] + gv[bj][1] * acc[ai][bj][m][1];
                    if (ob16) { u32x4 w; w.x = pk_bf16(x0[0], x0[1]); w.y = pk_bf16(x0[2], x0[3]); w.z = pk_bf16(x1[0], x1[1]); w.w = pk_bf16(x1[2], x1[3]); st16_wt((bf16_t*)u.o + off + bj * HALF, w); }
                    else { st16_wt((float*)u.o + off + bj * HALF, __builtin_bit_cast(u32x4, x0)); st16_wt((float*)u.o + off + bj * HALF + 4, __builtin_bit_cast(u32x4, x1)); } }
                asm volatile("" ::: "memory"); }
#undef RES_LOAD
        } else {
#pragma unroll
            for (int ai = 0; ai < 2; ++ai)
#pragma unroll
                for (int m = 0; m < 4; ++m) { bf16_t* op = (bf16_t*)u.o + (size_t)(row0 + ai * HALF + m * 16) * 1024 + col0;
#pragma unroll
                    for (int bj = 0; bj < 2; ++bj) { const f32x4 v0 = acc[ai][bj][m][0], v1 = acc[ai][bj][m][1];
                        u32x4 w; w.x = pk_bf16(v0[0], v0[1]); w.y = pk_bf16(v0[2], v0[3]); w.z = pk_bf16(v1[0], v1[1]); w.w = pk_bf16(v1[2], v1[3]); st16_wt(op + bj * HALF, w); } }
        }
    }
};
struct EpiSwiglu {
    static constexpr bool PERM = false;
    __device__ __forceinline__ void operator()(const f32x4 (&acc)[2][2][4][2], const Unit& u, int wr, int wc, int fr, int fq) const {
        const int row0 = wr * 64 + fr, col0 = wc * 32 + 8 * fq;
#pragma unroll
        for (int ai = 0; ai < 2; ++ai) if (ai == 0 || u.half == 0)
#pragma unroll
            for (int m = 0; m < 4; ++m) { bf16_t* rowp = (bf16_t*)u.o + (size_t)(row0 + ai * HALF + m * 16) * u.ldo + col0; float r[8];
#pragma unroll
                for (int bj = 0; bj < 2; ++bj) { const f32x4 a = acc[ai][bj][m][0], b = acc[ai][bj][m][1];
#pragma unroll
                    for (int e = 0; e < 4; ++e) r[bj * 4 + e] = a[e] * b[e] * __builtin_amdgcn_rcpf(1.f + __expf(-a[e])); }
                u32x4 w; w.x = pk_bf16(r[0], r[1]); w.y = pk_bf16(r[2], r[3]); w.z = pk_bf16(r[4], r[5]); w.w = pk_bf16(r[6], r[7]); st16_wt(rowp, w); }
    }
};
}
using g8::Unit;

struct SchedInproj {
    g8::ListOrderH L; unsigned char* ws; int l1; size_t wo;
    __device__ __forceinline__ bool next(int i, Unit& u) const {
        int q, hf; if (!L.idx(i, q, hf)) return false;
        const char* H = (const char*)(ws + OFF_HY);
        u.p1 = nullptr; u.p2 = nullptr; u.nt = 16; u.mode = 0; u.half = 0; u.mk = -1; u.mneg = 0;
        int kind, pm, pn, bt = 0;
        if (!l1) { if (q < 504) { kind = 0; const int gid = q / 56, rem = q % 56; pm = gid * 8 + (rem & 7); pn = rem >> 3; } else if (q < 760) { const int s = q - 504; kind = 1; bt = s >> 5; pn = (s & 31) >> 2; pm = s & 3; } else { const int s = q - 760; kind = 2; bt = s >> 2; pm = s & 3; pn = 0; } }
        else { if (q < 448) { kind = 0; const int gid = q / 56, rem = q % 56; pm = gid * 8 + (rem & 7); pn = rem >> 3; } else if (q < 488) { const int s = q - 448, r5 = s % 5; kind = 0; pm = 64 + s / 5; pn = r5 < 4 ? r5 + 1 : 6; }
               else if (q < 744) { const int s = q - 488; kind = 1; bt = s >> 5; pn = (s & 31) >> 2; pm = s & 3; } else { const int s = q - 744; kind = 2; bt = s / 3; pm = 1 + s % 3; pn = 0; } }
        if (kind == 0) {
            u.a = H + (size_t)pm * 256 * 2048; u.b = (const char*)(ws + OFF_WZ + wo) + (size_t)pn * 256 * 2048;
            u.o = (char*)(ws + OFF_Z) + ((size_t)pm * 256 * ZLD + pn * 256) * 2; u.ldo = ZLD; u.cmax = ZLD - pn * 256;
        } else if (kind == 1) {
            u.a = (const char*)(ws + OFF_WSW + wo) + (size_t)pm * 256 * 2048; u.b = H + ((size_t)bt * 2048 + pn * 256) * 2048;
            u.o = (char*)(ws + OFF_TLAT) + (((size_t)bt * 1024 + pm * 256) * 2048 + pn * 256) * 2; u.ldo = 2048; u.cmax = 256;
        } else {
            u.a = (const char*)(ws + OFF_WSW + wo) + (size_t)pm * 256 * 2048; u.b = H + ((size_t)MLAT + bt * 256) * 2048;
            u.o = (char*)(ws + OFF_TCTX) + (((size_t)bt * 1024 + pm * 256) * 256) * 2; u.ldo = 256; u.cmax = 256; }
        if (hf) { u.half = 1; if (hf == 2) { u.a += (size_t)128 * 2048; u.o += (size_t)128 * u.ldo * 2; } }
        return true;
    }
};
struct SchedF1Lat {
    g8::ListOrder L; unsigned char* ws;
    __device__ __forceinline__ bool next(int i, Unit& u) const {
        int q; if (!L.idx(i, q)) return false;
        const int bt = q >> 3, isq = (q >> 2) & 1, pm = q & 3;
        u.a = (const char*)(ws + OFF_TL) + (size_t)(isq * 8 + pm) * 256 * 4096; u.b = (const char*)(ws + OFF_TLAT) + (size_t)bt * 1024 * 4096;
        u.o = (char*)(ws + OFF_PQ) + (((size_t)bt * 2048 + pm * 256) * 512 + isq * 256) * 2; u.ldo = 512; u.cmax = 256; u.p2 = nullptr; u.nt = 32; u.mode = 0; u.half = 0;
        u.p1 = (const float*)((bf16_t*)(ws + OFF_PQ) + ((size_t)bt * 2048) * 512 + isq * 256); u.mk = pm * 256; u.mneg = isq;
        return true;
    }
};
__device__ __forceinline__ void fourier_mid_row(int wv, const Params& p) {
    const int tid = otid(wv), lane = tid & 63, gw = blockIdx.x * 8 + (tid >> 6), nw = gridDim.x * 8;
    const bf16_t* TLAT = (const bf16_t*)(p.ws + OFF_TLAT); bf16_t* PQ = (bf16_t*)(p.ws + OFF_PQ);
    for (int pr = gw; pr < 2048; pr += nw) { const int bt = pr >> 8, ch = pr & 255;
        const bf16_t* src = TLAT + ((size_t)bt * 1024 + ch) * 2048 + lane * 32; float acc = 0.f;
#pragma unroll
        for (int j = 0; j < 4; ++j) { const u32x4 w = *(const u32x4*)(src + j * 8);
            acc += (bflo(w.x) - bfhi(w.x)) + (bflo(w.y) - bfhi(w.y)) + (bflo(w.z) - bfhi(w.z)) + (bflo(w.w) - bfhi(w.w)); }
#pragma unroll
        for (int o = 32; o >= 1; o >>= 1) acc += shx(acc, o, lane);
        if (lane == 0) { PQ[((size_t)bt * 2048 + 1024) * 512 + ch] = f2bf(acc * 0.022097086912079608f); PQ[((size_t)bt * 2048 + 1024) * 512 + 256 + ch] = 0; } }
}
struct SchedF1Ctx {
    g8::ListOrder L; unsigned char* ws;
    __device__ __forceinline__ bool next(int i, Unit& u) const {
        int q; if (!L.idx(i, q)) return false;
        const int bt = q >> 1, pm = q & 1;
        u.a = (const char*)(ws + OFF_TC) + (size_t)pm * 256 * 512; u.b = (const char*)(ws + OFF_TCTX) + (size_t)bt * 1024 * 512;
        u.o = (char*)(ws + OFF_PQ) + (((size_t)MLAT + bt * 256) * 512 + pm * 256) * 2; u.ldo = 512; u.cmax = 256; u.p1 = nullptr; u.p2 = nullptr; u.nt = 4; u.mode = 0; u.half = 0; u.mk = -1; u.mneg = 0;
        return true;
    }
};
struct SchedF2 {
    g8::ListOrder L; unsigned char* ws; size_t wo;
    __device__ __forceinline__ bool next(int i, Unit& u) const {
        int q; if (!L.idx(i, q)) return false;
        u.a = (const char*)(ws + OFF_PQ) + (size_t)q * 256 * 1024; u.b = (const char*)(ws + OFF_WF + wo);
        u.o = (char*)(ws + OFF_HY) + (size_t)q * 256 * 2048; u.ldo = 1024; u.cmax = 256; u.p1 = nullptr; u.p2 = nullptr; u.nt = 8; u.mode = 0; u.half = 0; u.mk = -1; u.mneg = 0;
        return true;
    }
};
struct SchedRes {
    int G, c, with_ctx, nsp, ntk, ntp;
    unsigned char* ws; const char* A; size_t a_tile_bytes; const char* Bt; size_t b_tile_bytes;
    const void* base_lat; void* out_lat; int flags; const float* gate;
    __device__ __forceinline__ bool next(int i, Unit& u) const {
        u.ldo = 1024; u.cmax = flags;
        const int r0 = (256 + G - 1) / G;
        if (i < r0) { g8::ListOrder L{256, G, c}; int q; if (!L.idx(i, q)) return false;
            const int pm = q >> 2, pn = q & 3; const size_t ro = (size_t)pm * 256 * 1024 + pn * 256;
            u.a = A + (size_t)pm * a_tile_bytes; u.b = Bt + (size_t)pn * b_tile_bytes;
            u.p1 = (flags & 1) ? (const float*)((const bf16_t*)base_lat + ro) : (const float*)base_lat + ro;
            u.o = (flags & 2) ? (char*)((bf16_t*)out_lat + ro) : (char*)((float*)out_lat + ro);
            u.p2 = gate + (size_t)(pm >> 3) * 6144 + pn * 256; u.nt = ntk; u.mode = 0; u.half = 0; u.mk = -1; u.mneg = 0; return true; }
        if (!with_ctx) return false;
        g8::ListOrder L{32 * nsp, G, c}; int q; if (!L.idx(i - r0, q)) return false;
        const int un = q / nsp, part = q % nsp, pm = un >> 2, pn = un & 3, k0 = part * ntp; const size_t ro = (size_t)pm * 256 * 1024 + pn * 256;
        u.a = A + (size_t)(64 + pm) * a_tile_bytes + (size_t)k0 * 128; u.b = Bt + (size_t)pn * b_tile_bytes + (size_t)k0 * 128;
        u.p1 = nullptr; u.o = (char*)(ws + OFF_S) + ((size_t)part * 2048 * 1024 + ro) * 2; u.p2 = gate + (size_t)8 * 6144 + pn * 256;
        u.nt = (part == nsp - 1) ? (ntk - k0) : ntp; u.mode = 1; u.half = 0; u.mk = -1; u.mneg = 0; return true;
    }
};
struct SchedFfn1 {
    g8::ListOrderH L; unsigned char* ws; size_t wo;
    __device__ __forceinline__ bool next(int i, Unit& u) const {
        int q, hf; if (!L.idx(i, q, hf)) return false;
        const int gid = q / 176, rem = q % 176, pm = gid * 8 + (rem & 7), pn = rem >> 3;
        u.a = (const char*)(ws + OFF_HY) + (size_t)pm * 256 * 2048; u.b = (const char*)(ws + OFF_W13 + wo) + (size_t)pn * 256 * 2048;
        u.o = (char*)(ws + OFF_U) + ((size_t)pm * 256 * DFF + pn * 128) * 2; u.ldo = DFF; u.cmax = 128; u.p1 = nullptr; u.p2 = nullptr; u.nt = 16; u.mode = 0; u.half = 0; u.mk = -1; u.mneg = 0;
        if (hf) { u.half = 1; if (hf == 2) { u.a += (size_t)128 * 2048; u.o += (size_t)128 * DFF * 2; } }
        return true;
    }
};

__device__ __forceinline__ void phase0(int wv, const Params& p, LAS unsigned char* lds, int cb_first, int cb_stride, int cb_lo, int cb_hi, bool do_rope) {
    const int tid = otid(wv);
    float* mod = (float*)(p.ws + OFF_MOD);
    LAS float* sc = (LAS float*)lds;
    LAS float* part = (LAS float*)(lds + 36864);
    for (int cb = cb_lo + cb_first; cb < cb_hi; cb += cb_stride) {
        __syncthreads();
        for (int e = tid; e < 9216; e += 512) { const int i = e >> 10, k = e & 1023; const float v = (i < 8) ? p.c[i * 1024 + k] : p.c_ctx[k]; sc[e] = v / (1.f + expf(-v)); }
        __syncthreads();
        const int l = cb / 96, nb = cb % 96, nl = tid & 63, ks = tid >> 6;
        const float* w = p.ada_w + ((size_t)l * 1024 + ks * 128) * 6144 + nb * 64 + nl;
        float acc[9];
#pragma unroll
        for (int i = 0; i < 9; ++i) acc[i] = 0.f;
        for (int k0 = 0; k0 < 128; k0 += 16) { float wq[16];
#pragma unroll
            for (int u = 0; u < 16; ++u) wq[u] = w[(size_t)(k0 + u) * 6144];
#pragma unroll
            for (int u = 0; u < 16; ++u)
#pragma unroll
                for (int i = 0; i < 9; ++i) acc[i] += sc[i * 1024 + ks * 128 + k0 + u] * wq[u]; }
#pragma unroll
        for (int i = 0; i < 9; ++i) part[(ks * 9 + i) * 64 + nl] = acc[i];
        __syncthreads();
        for (int e = tid; e < 576; e += 512) { const int i = e >> 6, nn = e & 63; float s = 0.f;
#pragma unroll
            for (int k2 = 0; k2 < 8; ++k2) s += part[(k2 * 9 + i) * 64 + nn];
            mod[((size_t)l * 9 + i) * 6144 + nb * 64 + nn] = s + p.ada_b[l * 6144 + nb * 64 + nn]; }
    }
    const size_t gtid = (size_t)blockIdx.x * 512 + tid;
    if (do_rope && gtid < 768) { const int pos = (int)gtid / 12, i = (int)gtid % 12; float sn, cn; sincosf((float)pos * exp2f(-(float)i * 1.1073093649624542f), &sn, &cn);
        float* rp = (float*)(p.ws + OFF_ROPE) + gtid * 2; rp[0] = cn; rp[1] = sn; }
}

__device__ __forceinline__ void trig_tables(int wv, const Params& p, LAS unsigned char* lds, int first, int nblk) {
    const int tid = otid(wv);
    const size_t gtid = (size_t)first * 512 + tid, gstride = (size_t)nblk * 512;
    __syncthreads();
    LAS float* ct = (LAS float*)lds; LAS float* st = ct + 2048;
    for (int e = tid; e < 2048; e += 512) { const float ang = (float)e * (1.0f / 1024.0f); ct[e] = cospif(ang); st[e] = sinpif(ang); }
    __syncthreads();
    unsigned* TL = (unsigned*)(p.ws + OFF_TL);
    for (size_t e = gtid; e < (size_t)4096 * 1024; e += gstride) {
        const int r = (int)(e >> 10), l0 = (int)(e & 1023) * 2, rr = r & 2047; const LAS float* tb = r < 2048 ? ct : st;
        const float v0 = tb[(rr * l0) & 2047] * 0.022097086912079608f, v1 = tb[(rr * (l0 + 1)) & 2047] * 0.022097086912079608f;
        TL[e] = pk_bf16(v0, v1);
    }
    unsigned* TC = (unsigned*)(p.ws + OFF_TC);
    for (size_t e = gtid; e < (size_t)512 * 128; e += gstride) {
        const int r = (int)(e >> 7), l0 = (int)(e & 127) * 2, rr = r & 255; const LAS float* tb = r < 256 ? ct : st;
        const float v0 = tb[((rr * l0) & 255) * 8] * 0.0625f, v1 = tb[((rr * (l0 + 1)) & 255) * 8] * 0.0625f;
        TC[e] = pk_bf16(v0, v1);
    }
    __syncthreads();
}

__device__ __forceinline__ void phase_norm(int wv, const Params& p, int l, int which, int nrows, int nparts, const float* rgate) {
    const int tid = otid(wv), lane = tid & 63, gw = blockIdx.x * 8 + (tid >> 6), nw = gridDim.x * 8;
    const float* mod = (const float*)(p.ws + OFF_MOD) + (size_t)l * 9 * 6144;
    const float* gain = (which ? p.norm_ffn : p.norm_mix) + l * 1024;
    bf16_t* H = (bf16_t*)(p.ws + OFF_HY);
    const bf16_t* XB = (const bf16_t*)(p.ws + OFF_XB);
    const bool wide = !(l == 0 && which == 0);
    int cq[4];
#pragma unroll
    for (int q = 0; q < 4; ++q) cq[q] = wide ? (q >> 1) * 512 + lane * 8 + (q & 1) * 4 : q * 256 + lane * 4;
    for (int row0 = gw; row0 < nrows; row0 += 3 * nw) {
        f32x4 v[3][4]; float ss[3];
#pragma unroll
        for (int u = 0; u < 3; ++u) { const int row = row0 + u * nw; ss[u] = 0.f;
            if (row < nrows) { const bool lat = row < MLAT;
                if (!wide) { const float* src = lat ? p.x + (size_t)row * 1024 : p.ctx + (size_t)(row - MLAT) * 1024;
#pragma unroll
                    for (int q = 0; q < 4; ++q) v[u][q] = *(const f32x4*)(src + cq[q]); }
                else {
#pragma unroll
                    for (int jj = 0; jj < 2; ++jj) { const u32x4 w = *(const u32x4*)(XB + (size_t)row * 1024 + jj * 512 + lane * 8);
                        v[u][2 * jj] = (f32x4){bflo(w.x), bfhi(w.x), bflo(w.y), bfhi(w.y)}; v[u][2 * jj + 1] = (f32x4){bflo(w.z), bfhi(w.z), bflo(w.w), bfhi(w.w)}; } } }
            else {
#pragma unroll
                for (int q = 0; q < 4; ++q) v[u][q] = (f32x4){0.f, 0.f, 0.f, 0.f}; } }
#pragma unroll
        for (int u = 0; u < 3; ++u) { const int row = row0 + u * nw;
            if (row < nrows) { const bool lat = row < MLAT; const bool cpy = (l == 0 && which == 0 && !lat);
                if (!lat && nparts > 0) {
#pragma unroll
                    for (int jj = 0; jj < 2; ++jj) { f32x4 s0 = (f32x4){0.f, 0.f, 0.f, 0.f}, s1 = s0;
                        for (int pt = 0; pt < nparts; ++pt) { const u32x4 w = *(const u32x4*)((const bf16_t*)(p.ws + OFF_S) + (size_t)pt * 2048 * 1024 + (size_t)(row - MLAT) * 1024 + jj * 512 + lane * 8);
                            s0 += (f32x4){bflo(w.x), bfhi(w.x), bflo(w.y), bfhi(w.y)}; s1 += (f32x4){bflo(w.z), bfhi(w.z), bflo(w.w), bfhi(w.w)}; }
                        v[u][2 * jj] += *(const f32x4*)(rgate + cq[2 * jj]) * s0; v[u][2 * jj + 1] += *(const f32x4*)(rgate + cq[2 * jj + 1]) * s1;
                        u32x4 w; w.x = pk_bf16(v[u][2 * jj][0], v[u][2 * jj][1]); w.y = pk_bf16(v[u][2 * jj][2], v[u][2 * jj][3]); w.z = pk_bf16(v[u][2 * jj + 1][0], v[u][2 * jj + 1][1]); w.w = pk_bf16(v[u][2 * jj + 1][2], v[u][2 * jj + 1][3]);
                        *(u32x4*)((bf16_t*)(p.ws + OFF_XB) + (size_t)row * 1024 + jj * 512 + lane * 8) = w; } }
#pragma unroll
                for (int q = 0; q < 4; ++q) {
                    if (cpy) { u32x2 w; w.x = pk_bf16(v[u][q][0], v[u][q][1]); w.y = pk_bf16(v[u][q][2], v[u][q][3]); *(u32x2*)((bf16_t*)(p.ws + OFF_XB) + (size_t)row * 1024 + cq[q]) = w; }
                    ss[u] += v[u][q][0] * v[u][q][0] + v[u][q][1] * v[u][q][1] + v[u][q][2] * v[u][q][2] + v[u][q][3] * v[u][q][3]; } } }
#pragma unroll
        for (int o = 32; o >= 1; o >>= 1) {
#pragma unroll
            for (int u = 0; u < 3; ++u) ss[u] += shx(ss[u], o, lane); }
#pragma unroll
        for (int u = 0; u < 3; ++u) { const int row = row0 + u * nw;
            if (row < nrows) { const bool lat = row < MLAT; const int bi = lat ? (row >> 11) : 8;
                const float* sh = mod + (size_t)bi * 6144 + (which ? 3072 : 0);
                const float* sl = mod + (size_t)bi * 6144 + (which ? 4096 : 1024);
                const float rs = rsqrtf(ss[u] * (1.0f / 1024.0f) + 1e-6f);
                unsigned pk[4][2];
#pragma unroll
                for (int q = 0; q < 4; ++q) { const f32x4 g = *(const f32x4*)(gain + cq[q]), s1 = *(const f32x4*)(sl + cq[q]), s0 = *(const f32x4*)(sh + cq[q]); float r[4];
#pragma unroll
                    for (int e = 0; e < 4; ++e) r[e] = v[u][q][e] * rs * g[e] * (1.f + s1[e]) + s0[e];
                    pk[q][0] = pk_bf16(r[0], r[1]); pk[q][1] = pk_bf16(r[2], r[3]); }
                if (wide) {
#pragma unroll
                    for (int jj = 0; jj < 2; ++jj) { u32x4 w; w.x = pk[2 * jj][0]; w.y = pk[2 * jj][1]; w.z = pk[2 * jj + 1][0]; w.w = pk[2 * jj + 1][1]; *(u32x4*)(H + (size_t)row * 1024 + jj * 512 + lane * 8) = w; } }
                else {
#pragma unroll
                    for (int q = 0; q < 4; ++q) { u32x2 w; w.x = pk[q][0]; w.y = pk[q][1]; *(u32x2*)(H + (size_t)row * 1024 + cq[q]) = w; } } } }
    }
}

__device__ __forceinline__ void phase_weights(int wv, const Params& p, int l, LAS unsigned char* lds, int first, int stride) {
    const size_t wo = (size_t)0 * WSET;
    asm volatile("" : "+s"(stride));
    const int tid = otid(wv);
    LAS float* tile = (LAS float*)lds;
    LAS float* cs = (LAS float*)(lds + 33792);
    if (tid < 64) { cs[tid] = cospif((float)tid * (1.0f / 32.0f)); cs[64 + tid] = sinpif((float)tid * (1.0f / 32.0f)); }
    const int nl = tid & 63, kq = tid >> 6;
    float rg[16];
    const float* sp = nullptr; int ld = 0, k0 = 0, n0 = 0, K = 0; bf16_t* dst = nullptr;
    int ti = first;
#define WT_DECODE(TI) do { int mat; \
        if ((TI) < 1184) { const int nt = (TI) >> 3; k0 = ((TI) & 7) * 128; K = 1024; \
            if (nt < 16) { mat = 0; n0 = nt * 64; dst = (bf16_t*)(p.ws + OFF_WSW + wo); } \
            else if (nt < 44) { mat = 1; n0 = (nt - 16) * 64; dst = (bf16_t*)(p.ws + OFF_WZ + wo); } \
            else if (nt < 132) { mat = 2; n0 = (nt - 44) * 64; dst = (bf16_t*)(p.ws + OFF_W13 + wo); } \
            else { mat = 3; n0 = (nt - 132) * 64; dst = (bf16_t*)(p.ws + OFF_WOUT + wo); } \
        } else { const int t2 = (TI) - 1184; mat = 4; n0 = (t2 / 22) * 64; k0 = (t2 % 22) * 128; K = 2816; dst = (bf16_t*)(p.ws + OFF_W2 + wo); } \
        const int n = n0 + nl; sp = nullptr; ld = 0; \
        if (mat == 0) { const int col = n < 256 ? n : (n < 640 ? 1024 + (n - 256) : 1792 + (n - 640)); sp = p.w_in + (size_t)l * 1024 * NINW + col; ld = NINW; } \
        else if (mat == 1) { if (n < ZLD) { const int col = n < 768 ? 256 + n : (n < 1152 ? 1408 + (n - 768) : 2176 + (n - 1152)); sp = p.w_in + (size_t)l * 1024 * NINW + col; ld = NINW; } } \
        else if (mat == 2) { const int i2 = n & 15, J = (n >> 8) * 128 + ((n >> 5) & 3) * 32 + (i2 >> 2) * 8 + ((n >> 7) & 1) * 4 + (i2 & 3); sp = ((n & 16) ? p.ffn_w3 : p.ffn_w1) + (size_t)l * 1024 * DFF + J; ld = DFF; } \
        else if (mat == 3) { sp = p.w_out + (size_t)l * 1024 * 1024 + n; ld = 1024; } \
        else { sp = p.ffn_w2 + (size_t)l * DFF * 1024 + n; ld = 1024; } } while (0)
#define WT_LOAD() do { _Pragma("unroll") for (int i = 0; i < 16; ++i) rg[i] = sp ? sp[(size_t)(k0 + kq + i * 8) * ld] : 0.f; } while (0)
    if (ti < 1536) { WT_DECODE(ti); WT_LOAD(); }
    while (ti < 1536) {
        bf16_t* cdst = dst + (size_t)n0 * K + k0; const int cK = K;
        __syncthreads();
#pragma unroll
        for (int i = 0; i < 16; ++i) tile[(kq + i * 8) * 65 + nl] = rg[i];
        ti += stride;
        if (ti < 1536) { WT_DECODE(ti); WT_LOAD(); }
        __syncthreads();
        { const int nn = tid >> 3, ks = tid & 7; float v[16];
#pragma unroll
            for (int j = 0; j < 16; ++j) v[j] = tile[(ks * 16 + j) * 65 + nn];
            u32x4 w0, w1; w0.x = pk_bf16(v[0], v[1]); w0.y = pk_bf16(v[2], v[3]); w0.z = pk_bf16(v[4], v[5]); w0.w = pk_bf16(v[6], v[7]);
            w1.x = pk_bf16(v[8], v[9]); w1.y = pk_bf16(v[10], v[11]); w1.z = pk_bf16(v[12], v[13]); w1.w = pk_bf16(v[14], v[15]);
            bf16_t* o = cdst + (size_t)nn * cK + ks * 16; *(u32x4*)o = w0; *(u32x4*)(o + 8) = w1; }
    }
#undef WT_DECODE
#undef WT_LOAD
    __syncthreads();
    bf16_t* WF = (bf16_t*)(p.ws + OFF_WF + wo);
    const float* fw = p.fnet_w + (size_t)l * 65536;
    for (int idx = first * 512 + tid; idx < 131072; idx += stride * 512) {
        const int n = idx & 255, k = idx >> 8, part = k >> 8, g = (k & 255) >> 6, j = k & 63; float s = 0.f;
        for (int m = 0; m < 64; ++m) s += cs[part * 64 + ((m * j) & 63)] * fw[(size_t)(g * 64 + m) * 256 + n];
        WF[(size_t)n * 512 + k] = f2bf(part ? -0.125f * s : 0.125f * s);
    }
}

constexpr int NA_KLOC = 0, NA_VLOC = 36864, NA_KCTX = 70656, NA_VCTX = 89088, NA_RPB = 106496;
__device__ __forceinline__ u32x4 norm_krow(u32x4 w, int lane) {
    float v[8]; v[0] = bflo(w.x); v[1] = bfhi(w.x); v[2] = bflo(w.y); v[3] = bfhi(w.y); v[4] = bflo(w.z); v[5] = bfhi(w.z); v[6] = bflo(w.w); v[7] = bfhi(w.w);
    float ss = 0.f;
#pragma unroll
    for (int e = 0; e < 8; ++e) ss += v[e] * v[e];
    ss += shx(ss, 1, lane); ss += shx(ss, 2, lane); ss += shx(ss, 4, lane);
    const float rk = rsqrtf(ss * (1.0f / 64.0f) + 1e-6f);
    u32x4 o; o.x = pk_bf16(v[0] * rk, v[1] * rk); o.y = pk_bf16(v[2] * rk, v[3] * rk); o.z = pk_bf16(v[4] * rk, v[5] * rk); o.w = pk_bf16(v[6] * rk, v[7] * rk); return o;
}
constexpr int NB_KLOC = 0, NB_VLOC = 46080, NB_KCTX = 88064, NB_VCTX = 106496, NB_RPB = 123904;
template <int ND>
__device__ __forceinline__ void na_step(LAS unsigned char* lds, int kbase, int vbase, int vstr, const int (&key0)[ND], bool loc, const int (&dr)[ND], const LAS float* rpb,
                                        const bf16x8 (&qf)[2], int fr, int fq, int lane, int cst, int cq, int c0w, float& m_run, float& l_run, f32x4 (&O)[4]) {
    f32x4 sc[2 * ND];
#pragma unroll
    for (int u = 0; u < 2 * ND; ++u) sc[u] = (f32x4){0.f, 0.f, 0.f, 0.f};
    __builtin_amdgcn_s_setprio(1);
#pragma unroll
    for (int kk = 0; kk < 2; ++kk)
#pragma unroll
        for (int u = 0; u < 2 * ND; ++u) {
            const bf16x8 kf = *(const LAS bf16x8*)(lds + kbase + (key0[u >> 1] + (u & 1) * 16 + fr) * 144 + kk * 64 + fq * 16);
            sc[u] = mfma16(kf, qf[kk], sc[u]); }
    __builtin_amdgcn_s_setprio(0);
    if (loc) {
#pragma unroll
        for (int g = 0; g < ND; ++g)
#pragma unroll
            for (int i = 0; i < 4; ++i) {
                const int ck0 = cst + fq * 4 + i, ck1 = ck0 + 16;
                const int rel0 = min(max(ck0 - cq + 15, 0), 30), rel1 = min(max(ck1 - cq + 15, 0), 30);
                const bool v0 = (ck0 >= c0w) && (ck0 < c0w + 16), v1 = (ck1 >= c0w) && (ck1 < c0w + 16);
                sc[2 * g][i] = v0 ? sc[2 * g][i] + rpb[dr[g] * 31 + rel0] : -INFINITY;
                sc[2 * g + 1][i] = v1 ? sc[2 * g + 1][i] + rpb[dr[g] * 31 + rel1] : -INFINITY; }
    }
    float mx = -INFINITY;
#pragma unroll
    for (int u = 0; u < 2 * ND; ++u) mx = fmaxf(mx, fmaxf(fmaxf(sc[u][0], sc[u][1]), fmaxf(sc[u][2], sc[u][3])));
    mx = xmax16(mx); mx = xmax32(mx);
    const float m_new = fmaxf(m_run, mx);
    const float m_use = (m_new == -INFINITY) ? 0.f : m_new;
    const float alpha = __builtin_amdgcn_exp2f(m_run - m_use);
    float ps_sum = 0.f; bf16x8 pf[ND];
#pragma unroll
    for (int g = 0; g < ND; ++g) { float pv[8];
#pragma unroll
        for (int i = 0; i < 4; ++i) { pv[i] = __builtin_amdgcn_exp2f(sc[2 * g][i] - m_use); pv[4 + i] = __builtin_amdgcn_exp2f(sc[2 * g + 1][i] - m_use); ps_sum += pv[i] + pv[4 + i]; }
        u32x4 pw; pw.x = pk_bf16(pv[0], pv[1]); pw.y = pk_bf16(pv[2], pv[3]); pw.z = pk_bf16(pv[4], pv[5]); pw.w = pk_bf16(pv[6], pv[7]);
        pf[g] = as_bf8(pw); }
    l_run = l_run * alpha + ps_sum; m_run = m_new;
    __builtin_amdgcn_s_setprio(1);
#pragma unroll
    for (int d = 0; d < 4; ++d) { O[d] = O[d] * alpha;
#pragma unroll
        for (int g = 0; g < ND; ++g) {
            const u32x2 va = *(const LAS u32x2*)(lds + vbase + (d * 16 + fr) * vstr + (key0[g] + fq * 4) * 2);
            const u32x2 vb = *(const LAS u32x2*)(lds + vbase + (d * 16 + fr) * vstr + (key0[g] + 16 + fq * 4) * 2);
            u32x4 vw; vw.x = va.x; vw.y = va.y; vw.z = vb.x; vw.w = vb.y;
            O[d] = mfma16(as_bf8(vw), pf[g], O[d]); } }
    __builtin_amdgcn_s_setprio(0);
}
__device__ __forceinline__ void na_item(int wv, const Params& p, int l, int it, LAS unsigned char* lds) {
    const int tid = otid(wv), lane = tid & 63, wave = __builtin_amdgcn_readfirstlane(tid >> 6), fr = lane & 15, fq = lane >> 4;
    const bf16_t* Z = (const bf16_t*)(p.ws + OFF_Z); const bf16_t* TLAT = (const bf16_t*)(p.ws + OFF_TLAT); const bf16_t* TCTX = (const bf16_t*)(p.ws + OFF_TCTX);
    bf16_t* Y = (bf16_t*)(p.ws + OFF_HY);
    const bool lat = it < 768; int b, h, rho = 0, g2 = 0;
    if (lat) { b = it / 96; const int rem = it % 96; h = rem >> 4; rho = rem & 15; } else { const int ci = it - 768; b = ci / 12; h = (ci % 12) >> 1; g2 = ci & 1; }
    const int r0a = min(max(2 * rho - 4, 0), 24), r0b = min(max(2 * rho - 3, 0), 24), dd = r0b - r0a;
    const int rsel = wave >> 2, j = wave & 3;
    const int r = 2 * rho + rsel, r0 = rsel ? r0b : r0a, off = rsel ? dd : 0;
    const int cst = (j == 0) ? 0 : (j == 1 ? 8 : (j == 2 ? 24 : 32));
    const int qrow = lat ? (b * 2048 + r * 64 + 16 * j + fr) : (MLAT + b * 256 + g2 * 128 + wave * 16 + fr);
    LAS float* rpb = (LAS float*)(lds + NB_RPB);
    bf16x8 qf[2];
    { const bf16_t* qp = Z + (size_t)qrow * ZLD + h * 64 + fq * 8;
      const u32x4 w0 = *(const u32x4*)qp, w1 = *(const u32x4*)(qp + 32);
      float v[16]; v[0] = bflo(w0.x); v[1] = bfhi(w0.x); v[2] = bflo(w0.y); v[3] = bfhi(w0.y); v[4] = bflo(w0.z); v[5] = bfhi(w0.z); v[6] = bflo(w0.w); v[7] = bfhi(w0.w);
      v[8] = bflo(w1.x); v[9] = bfhi(w1.x); v[10] = bflo(w1.y); v[11] = bfhi(w1.y); v[12] = bflo(w1.z); v[13] = bfhi(w1.z); v[14] = bflo(w1.w); v[15] = bfhi(w1.w);
      float ss = 0.f;
#pragma unroll
      for (int e = 0; e < 16; ++e) ss += v[e] * v[e];
      ss = xsum16(ss); ss = xsum32(ss);
      const float rq = rsqrtf(ss * (1.0f / 64.0f) + 1e-6f) * 0.125f * LOG2E;
      const float* gq = p.na_q_norm + l * 64; const float* gk = p.na_k_norm + l * 64;
#pragma unroll
      for (int e = 0; e < 8; ++e) { v[e] *= rq * gq[fq * 8 + e] * gk[fq * 8 + e]; v[8 + e] *= rq * gq[32 + fq * 8 + e] * gk[32 + fq * 8 + e]; }
      u32x4 a, c; a.x = pk_bf16(v[0], v[1]); a.y = pk_bf16(v[2], v[3]); a.z = pk_bf16(v[4], v[5]); a.w = pk_bf16(v[6], v[7]);
      c.x = pk_bf16(v[8], v[9]); c.y = pk_bf16(v[10], v[11]); c.z = pk_bf16(v[12], v[13]); c.w = pk_bf16(v[14], v[15]);
      qf[0] = as_bf8(a); qf[1] = as_bf8(c); }
    float m_run = -INFINITY, l_run = 0.f;
    f32x4 O[4];
#pragma unroll
    for (int d = 0; d < 4; ++d) O[d] = (f32x4){0.f, 0.f, 0.f, 0.f};
    const int cq = 16 * j + fr, c0w = min(max(cq - 8, 0), 48);
    u32x4 kl[5], vl[5], kc[2], vc[2];
#define NA_LOAD(PS) do { \
        if (lat) { const int nk = ((PS) ? 3 + dd : 5) * 64; const int tk0 = b * 2048 + (r0a + 5 * (PS)) * 64; \
            _Pragma("unroll") for (int i = 0; i < 5; ++i) { const int e = tid + i * 512, key = e >> 3, seg = e & 7; \
                kl[i] = (key < nk) ? *(const u32x4*)(Z + (size_t)(tk0 + key) * ZLD + ZC_NK + h * 64 + seg * 8) : (u32x4){0u, 0u, 0u, 0u}; } \
            _Pragma("unroll") for (int i = 0; i < 5; ++i) { const int e = tid + i * 512, d = e / 40, seg = e % 40; \
                vl[i] = (seg * 8 < nk) ? *(const u32x4*)(TLAT + ((size_t)(b * 1024 + TC_NV + h * 64 + d)) * 2048 + (r0a + 5 * (PS)) * 64 + seg * 8) : (u32x4){0u, 0u, 0u, 0u}; } } \
        _Pragma("unroll") for (int i = 0; i < 2; ++i) { const int e = tid + i * 512, key = e >> 3, seg = e & 7; \
            kc[i] = *(const u32x4*)(Z + (size_t)(MLAT + b * 256 + 128 * (PS) + key) * ZLD + ZC_NK + h * 64 + seg * 8); } \
        _Pragma("unroll") for (int i = 0; i < 2; ++i) { const int e = tid + i * 512, d = e >> 4, seg = e & 15; \
            vc[i] = *(const u32x4*)(TCTX + ((size_t)(b * 1024 + TC_NV + h * 64 + d)) * 256 + 128 * (PS) + seg * 8); } } while (0)
    NA_LOAD(0);
    for (int ps = 0; ps < 2; ++ps) {
        __syncthreads();
        if (ps == 0 && lat) for (int e = tid; e < 465; e += 512) rpb[e] = p.na_rpb[(size_t)(l * 6 + h) * 465 + e] * LOG2E;
        if (lat) {
#pragma unroll
            for (int i = 0; i < 5; ++i) { const int e = tid + i * 512, key = e >> 3, seg = e & 7; *(LAS u32x4*)(lds + NB_KLOC + key * 144 + seg * 16) = norm_krow(kl[i], lane); }
#pragma unroll
            for (int i = 0; i < 5; ++i) { const int e = tid + i * 512, d = e / 40, seg = e % 40; *(LAS u32x4*)(lds + NB_VLOC + d * 656 + seg * 16) = vl[i]; }
        }
#pragma unroll
        for (int i = 0; i < 2; ++i) { const int e = tid + i * 512, key = e >> 3, seg = e & 7; *(LAS u32x4*)(lds + NB_KCTX + key * 144 + seg * 16) = norm_krow(kc[i], lane); }
#pragma unroll
        for (int i = 0; i < 2; ++i) { const int e = tid + i * 512, d = e >> 4, seg = e & 15; *(LAS u32x4*)(lds + NB_VCTX + d * 272 + seg * 16) = vc[i]; }
        __syncthreads();
        if (ps == 0) NA_LOAD(1);
        if (lat) {
            const int p0 = 5 * ps, lo = max(off, p0), hi = min(off + 8, ps ? 9 : 5);
            int rel = lo;
            for (; rel + 1 < hi; rel += 2) { const int key0[2] = {(rel - p0) * 64 + cst, (rel + 1 - p0) * 64 + cst}; const int dr[2] = {(r0 + rel - off) - r + 7, (r0 + rel + 1 - off) - r + 7};
                na_step<2>(lds, NB_KLOC, NB_VLOC, 656, key0, true, dr, rpb, qf, fr, fq, lane, cst, cq, c0w, m_run, l_run, O); }
            if (rel < hi) { const int key0[1] = {(rel - p0) * 64 + cst}; const int dr[1] = {(r0 + rel - off) - r + 7};
                na_step<1>(lds, NB_KLOC, NB_VLOC, 656, key0, true, dr, rpb, qf, fr, fq, lane, cst, cq, c0w, m_run, l_run, O); }
        }
        { const int dr[4] = {0, 0, 0, 0}; const int key0[4] = {0, 32, 64, 96};
          na_step<4>(lds, NB_KCTX, NB_VCTX, 272, key0, false, dr, rpb, qf, fr, fq, lane, cst, cq, c0w, m_run, l_run, O); }
    }
#undef NA_LOAD
    l_run = xsum16(l_run); l_run = xsum32(l_run);
    const float inv = 1.0f / l_run;
#pragma unroll
    for (int d = 0; d < 4; ++d) { u32x2 w; w.x = pk_bf16(O[d][0] * inv, O[d][1] * inv); w.y = pk_bf16(O[d][2] * inv, O[d][3] * inv);
        *(u32x2*)(Y + (size_t)qrow * 1024 + 256 + h * 64 + d * 16 + fq * 4) = w; }
}

constexpr int GL_GT = 0, GL_G = 13824, GL_Q = 39424, GL_K = 57856, GL_VT = 76288, GL_X = 90112, GL_ST = 108544;
__device__ __forceinline__ int gla_row0(int b, int n) { return n < 32 ? b * 2048 + n * 64 : MLAT + b * 256 + (n - 32) * 64; }
struct PrepRegs { u32x4 ga[3]; u32x4 bw[3]; float bias[3]; };
__device__ __forceinline__ void gla_prep_load(PrepRegs& R, const Params& p, int l, int h, int row0, int wave, int fr, int fq) {
    const bf16_t* Z = (const bf16_t*)(p.ws + OFF_Z);
#pragma unroll
    for (int q = 0; q < 3; ++q) { const int tile = wave * 3 + q, mi = tile / 6, ni = tile % 6, dir = ni / 3, c = (ni % 3) * 16 + fr;
        R.ga[q] = *(const u32x4*)(Z + (size_t)(row0 + mi * 16 + fr) * ZLD + ZC_GA + fq * 8);
        R.bw[q] = (u32x4){0u, 0u, 0u, 0u};
        if ((fq >> 1) == dir) { const float* aw = p.gla_alpha_w + ((size_t)(l * 2 + dir) * 16 + (fq & 1) * 8) * 192 + h * 48 + c; float w[8];
#pragma unroll
            for (int e = 0; e < 8; ++e) w[e] = aw[e * 192];
            R.bw[q].x = pk_bf16(w[0], w[1]); R.bw[q].y = pk_bf16(w[2], w[3]); R.bw[q].z = pk_bf16(w[4], w[5]); R.bw[q].w = pk_bf16(w[6], w[7]); }
        R.bias[q] = p.gla_alpha_b[(size_t)(l * 2 + dir) * 192 + h * 48 + c]; }
}
__device__ __forceinline__ void gla_prep(const PrepRegs& R, LAS unsigned char* lds, int wave, int fr, int fq) {
    LAS float* G = (LAS float*)(lds + GL_G);
    __syncthreads();
#pragma unroll
    for (int q = 0; q < 3; ++q) { const int tile = wave * 3 + q, mi = tile / 6, ni = tile % 6, dir = ni / 3, c = (ni % 3) * 16 + fr;
        const f32x4 acc = mfma16(as_bf8(R.ga[q]), as_bf8(R.bw[q]), (f32x4){0.f, 0.f, 0.f, 0.f});
        float g[4];
#pragma unroll
        for (int i = 0; i < 4; ++i) { const float sv = acc[i] + R.bias[q]; g[i] = (fminf(sv, 0.f) - __logf(1.f + __expf(-fabsf(sv)))) * (1.0f / 16.0f); }
        u32x2 w2; w2.x = pk_bf16(g[0], g[1]); w2.y = pk_bf16(g[2], g[3]);
        *(LAS u32x2*)(lds + GL_GT + (dir * 48 + c) * 144 + (mi * 16 + fq * 4) * 2) = w2; }
    __syncthreads();
#pragma unroll
    for (int q = 0; q < 3; ++q) { const int tile = wave * 3 + q, mi = tile / 6, ni = tile % 6, dir = ni / 3;
        f32x4 acc = (f32x4){0.f, 0.f, 0.f, 0.f};
#pragma unroll
        for (int kk = 0; kk < 2; ++kk) { const int t = mi * 16 + fr; bf16x8 tri;
#pragma unroll
            for (int e = 0; e < 8; ++e) { const int sidx = kk * 32 + fq * 8 + e; tri[e] = (dir ? (sidx >= t) : (sidx <= t)) ? (short)0x3F80 : (short)0; }
            const bf16x8 bb = *(const LAS bf16x8*)(lds + GL_GT + (ni * 16 + fr) * 144 + kk * 64 + fq * 16);
            acc = mfma16(tri, bb, acc); }
#pragma unroll
        for (int i = 0; i < 4; ++i) G[(dir * 64 + mi * 16 + fq * 4 + i) * 48 + (ni % 3) * 16 + fr] = acc[i]; }
    __syncthreads();
}
__device__ __forceinline__ void gla_g1_item(int wv, const Params& p, int l, int it, LAS unsigned char* lds) {
    const int tid = otid(wv), lane = tid & 63, wave = tid >> 6, fr = lane & 15, fq = lane >> 4;
    const int b = it / 144, rem = it % 144, n = rem >> 2, h = rem & 3;
    const int row0 = gla_row0(b, n); const bool latent = n < 32;
    const bf16_t* Z = (const bf16_t*)(p.ws + OFF_Z);
    PrepRegs R; gla_prep_load(R, p, l, h, row0, wave, fr, fq);
    const int t3 = tid / 6, r6 = tid % 6, half = r6 / 3, j4 = (r6 % 3) * 4, c1 = half * 24 + j4;
    u32x2 w1 = (u32x2){0u, 0u}, w2 = (u32x2){0u, 0u}; f32x4 ra = (f32x4){1.f, 0.f, 1.f, 0.f}, rb = ra;
    if (tid < 384) { const bf16_t* zr = Z + (size_t)(row0 + t3) * ZLD + ZC_GK + h * 48 + c1; w1 = *(const u32x2*)zr; w2 = *(const u32x2*)(zr + 12);
        if (latent) { const float* rp = (const float*)(p.ws + OFF_ROPE) + ((half ? t3 : n) * 12 + j4) * 2; ra = *(const f32x4*)rp; rb = *(const f32x4*)(rp + 4); } }
    const bf16_t* vsrc = latent ? (const bf16_t*)(p.ws + OFF_TLAT) + ((size_t)(b * 1024 + TC_GV + h * 96)) * 2048 + n * 64
                                : (const bf16_t*)(p.ws + OFF_TCTX) + ((size_t)(b * 1024 + TC_GV + h * 96)) * 256 + (n - 32) * 64;
    const int vld = latent ? 2048 : 256;
    u32x4 vw[2];
#pragma unroll
    for (int i = 0; i < 2; ++i) { const int e = tid + i * 512; vw[i] = (e < 768) ? *(const u32x4*)(vsrc + (size_t)(e >> 3) * vld + (e & 7) * 8) : (u32x4){0u, 0u, 0u, 0u}; }
    gla_prep(R, lds, wave, fr, fq);
    LAS float* G = (LAS float*)(lds + GL_G);
    if (tid < 384) { const int t = t3;
        float x1[4] = {bflo(w1.x), bfhi(w1.x), bflo(w1.y), bfhi(w1.y)}, x2[4] = {bflo(w2.x), bfhi(w2.x), bflo(w2.y), bfhi(w2.y)};
        { const float cn[4] = {ra[0], ra[2], rb[0], rb[2]}, sn[4] = {ra[1], ra[3], rb[1], rb[3]};
#pragma unroll
            for (int e = 0; e < 4; ++e) { const float a1 = x1[e], a2 = x2[e]; x1[e] = a1 * cn[e] - a2 * sn[e]; x2[e] = a2 * cn[e] + a1 * sn[e]; } }
#pragma unroll
        for (int dir = 0; dir < 2; ++dir) { const int tl = dir ? 0 : 63;
            const f32x4 b1 = *(const LAS f32x4*)(G + (dir * 64 + t) * 48 + c1), b2 = *(const LAS f32x4*)(G + (dir * 64 + t) * 48 + c1 + 12);
            const f32x4 l1 = *(const LAS f32x4*)(G + (dir * 64 + tl) * 48 + c1), l2 = *(const LAS f32x4*)(G + (dir * 64 + tl) * 48 + c1 + 12);
#pragma unroll
            for (int e = 0; e < 4; ++e) {
                *(LAS bf16_t*)(lds + GL_X + (dir * 48 + c1 + e) * 144 + t * 2) = f2bf(x1[e] * __expf(l1[e] - b1[e]));
                *(LAS bf16_t*)(lds + GL_X + (dir * 48 + c1 + 12 + e) * 144 + t * 2) = f2bf(x2[e] * __expf(l2[e] - b2[e])); } } }
#pragma unroll
    for (int i = 0; i < 2; ++i) { const int e = tid + i * 512; if (e < 768) *(LAS u32x4*)(lds + GL_VT + (e >> 3) * 144 + (e & 7) * 16) = vw[i]; }
    bf16_t* Sb = (bf16_t*)(p.ws + OFF_S); float* DEC = (float*)(p.ws + OFF_DEC);
    if (tid < 96) { const int dir = tid / 48, c = tid % 48; const size_t slot = (size_t)((b * 4 + h) * 2 + dir) * 36 + n;
        DEC[slot * 48 + c] = __expf(dir ? G[64 * 48 + c] : G[63 * 48 + c]); }
    __syncthreads();
    for (int tl = wave; tl < 36; tl += 8) { const int dir = tl / 18, r2 = tl % 18, mi = r2 / 3, ni = r2 % 3;
        f32x4 acc = (f32x4){0.f, 0.f, 0.f, 0.f};
#pragma unroll
        for (int kk = 0; kk < 2; ++kk) {
            const bf16x8 a = *(const LAS bf16x8*)(lds + GL_VT + (mi * 16 + fr) * 144 + kk * 64 + fq * 16);
            const bf16x8 bb = *(const LAS bf16x8*)(lds + GL_X + (dir * 48 + ni * 16 + fr) * 144 + kk * 64 + fq * 16);
            acc = mfma16(a, bb, acc); }
        bf16_t* dst = Sb + ((size_t)((b * 4 + h) * 2 + dir) * 36 + n) * 4608;
#pragma unroll
        for (int i = 0; i < 4; ++i) dst[(mi * 16 + fq * 4 + i) * 48 + ni * 16 + fr] = f2bf(acc[i]); }
}
__device__ __forceinline__ void gla_g3_item(int wv, const Params& p, int l, int b, int n, int h, LAS unsigned char* lds) {
    const int tid = otid(wv), lane = tid & 63, wave = tid >> 6, fr = lane & 15, fq = lane >> 4;
    const int row0 = gla_row0(b, n); const bool latent = n < 32;
    const bf16_t* Z = (const bf16_t*)(p.ws + OFF_Z);
    PrepRegs R; gla_prep_load(R, p, l, h, row0, wave, fr, fq);
    const int t3 = tid / 6, r6 = tid % 6, half = r6 / 3, j4 = (r6 % 3) * 4, c1 = half * 24 + j4;
    u32x2 q1w = (u32x2){0u, 0u}, q2w = q1w, k1w = q1w, k2w = q1w; f32x4 ra = (f32x4){1.f, 0.f, 1.f, 0.f}, rb = ra;
    if (tid < 384) { const bf16_t* zq = Z + (size_t)(row0 + t3) * ZLD + ZC_GQ + h * 48 + c1; const bf16_t* zk = Z + (size_t)(row0 + t3) * ZLD + ZC_GK + h * 48 + c1;
        q1w = *(const u32x2*)zq; q2w = *(const u32x2*)(zq + 12); k1w = *(const u32x2*)zk; k2w = *(const u32x2*)(zk + 12);
        if (latent) { const float* rp = (const float*)(p.ws + OFF_ROPE) + ((half ? t3 : n) * 12 + j4) * 2; ra = *(const f32x4*)rp; rb = *(const f32x4*)(rp + 4); } }
    const bf16_t* Sb = (const bf16_t*)(p.ws + OFF_S);
    u32x4 sw[3];
#pragma unroll
    for (int i = 0; i < 3; ++i) { const int e = tid + i * 512; if (e < 1152) { const int dir = e / 576, idx = e % 576, dv = idx / 6, dk = (idx % 6) * 8;
            sw[i] = *(const u32x4*)(Sb + ((size_t)((b * 4 + h) * 2 + dir) * 36 + n) * 4608 + dv * 48 + dk); } else sw[i] = (u32x4){0u, 0u, 0u, 0u}; }
    const bf16_t* vsrc = latent ? (const bf16_t*)(p.ws + OFF_TLAT) + ((size_t)(b * 1024 + TC_GV + h * 96)) * 2048 + n * 64
                                : (const bf16_t*)(p.ws + OFF_TCTX) + ((size_t)(b * 1024 + TC_GV + h * 96)) * 256 + (n - 32) * 64;
    const int vld = latent ? 2048 : 256;
    u32x4 vw[2];
#pragma unroll
    for (int i = 0; i < 2; ++i) { const int e = tid + i * 512; vw[i] = (e < 768) ? *(const u32x4*)(vsrc + (size_t)(e >> 3) * vld + (e & 7) * 8) : (u32x4){0u, 0u, 0u, 0u}; }
    const int tf = tid >> 3, part = tid & 7;
    u32x2 ggw[3];
    { const bf16_t* gp = Z + (size_t)(row0 + tf) * ZLD + ZC_GG + h * 96 + part * 12;
#pragma unroll
      for (int q4 = 0; q4 < 3; ++q4) ggw[q4] = *(const u32x2*)(gp + q4 * 4); }
    gla_prep(R, lds, wave, fr, fq);
    LAS float* G = (LAS float*)(lds + GL_G);
    if (tid < 384) { const int t = t3;
        float q1[4] = {bflo(q1w.x), bfhi(q1w.x), bflo(q1w.y), bfhi(q1w.y)}, q2[4] = {bflo(q2w.x), bfhi(q2w.x), bflo(q2w.y), bfhi(q2w.y)};
        float k1[4] = {bflo(k1w.x), bfhi(k1w.x), bflo(k1w.y), bfhi(k1w.y)}, k2[4] = {bflo(k2w.x), bfhi(k2w.x), bflo(k2w.y), bfhi(k2w.y)};
        { const float cn[4] = {ra[0], ra[2], rb[0], rb[2]}, sn[4] = {ra[1], ra[3], rb[1], rb[3]};
#pragma unroll
            for (int e = 0; e < 4; ++e) { float a1 = q1[e], a2 = q2[e]; q1[e] = a1 * cn[e] - a2 * sn[e]; q2[e] = a2 * cn[e] + a1 * sn[e];
                a1 = k1[e]; a2 = k2[e]; k1[e] = a1 * cn[e] - a2 * sn[e]; k2[e] = a2 * cn[e] + a1 * sn[e]; } }
#pragma unroll
        for (int dir = 0; dir < 2; ++dir) {
            const f32x4 b1 = *(const LAS f32x4*)(G + (dir * 64 + t) * 48 + c1), b2 = *(const LAS f32x4*)(G + (dir * 64 + t) * 48 + c1 + 12);
            float e1[4], e2[4], i1[4], i2[4];
#pragma unroll
            for (int e = 0; e < 4; ++e) { e1[e] = __expf(b1[e]); e2[e] = __expf(b2[e]); i1[e] = __expf(-b1[e]); i2[e] = __expf(-b2[e]); }
            const float qs = 0.14433756729740643f;
            u32x2 w;
            w.x = pk_bf16(q1[0] * qs * e1[0], q1[1] * qs * e1[1]); w.y = pk_bf16(q1[2] * qs * e1[2], q1[3] * qs * e1[3]); *(LAS u32x2*)(lds + GL_Q + (dir * 64 + t) * 144 + c1 * 2) = w;
            w.x = pk_bf16(q2[0] * qs * e2[0], q2[1] * qs * e2[1]); w.y = pk_bf16(q2[2] * qs * e2[2], q2[3] * qs * e2[3]); *(LAS u32x2*)(lds + GL_Q + (dir * 64 + t) * 144 + (c1 + 12) * 2) = w;
            w.x = pk_bf16(k1[0] * i1[0], k1[1] * i1[1]); w.y = pk_bf16(k1[2] * i1[2], k1[3] * i1[3]); *(LAS u32x2*)(lds + GL_K + (dir * 64 + t) * 144 + c1 * 2) = w;
            w.x = pk_bf16(k2[0] * i2[0], k2[1] * i2[1]); w.y = pk_bf16(k2[2] * i2[2], k2[3] * i2[3]); *(LAS u32x2*)(lds + GL_K + (dir * 64 + t) * 144 + (c1 + 12) * 2) = w; } }
    for (int e = tid; e < 2048; e += 512) { const int rw = e >> 4, c = 48 + (e & 15);
        *(LAS bf16_t*)(lds + GL_Q + rw * 144 + c * 2) = 0; *(LAS bf16_t*)(lds + GL_K + rw * 144 + c * 2) = 0; }
#pragma unroll
    for (int i = 0; i < 3; ++i) { const int e = tid + i * 512; if (e < 1152) { const int dir = e / 576, idx = e % 576, dv = idx / 6, dk = (idx % 6) * 8;
            *(LAS u32x4*)(lds + GL_ST + (dir * 96 + dv) * 144 + dk * 2) = sw[i]; } }
    for (int e = tid; e < 3072; e += 512) { const int rw = e >> 4, c = 48 + (e & 15); *(LAS bf16_t*)(lds + GL_ST + rw * 144 + c * 2) = 0; }
#pragma unroll
    for (int i = 0; i < 2; ++i) { const int e = tid + i * 512; if (e < 768) *(LAS u32x4*)(lds + GL_VT + (e >> 3) * 144 + (e & 7) * 16) = vw[i]; }
    __syncthreads();
    { const int dir = wave >> 2, mi = wave & 3;
      bf16x8 a[2];
#pragma unroll
      for (int kk = 0; kk < 2; ++kk) a[kk] = *(const LAS bf16x8*)(lds + GL_Q + (dir * 64 + mi * 16 + fr) * 144 + kk * 64 + fq * 16);
#pragma unroll
      for (int ni = 0; ni < 4; ++ni) { f32x4 acc = (f32x4){0.f, 0.f, 0.f, 0.f};
#pragma unroll
          for (int kk = 0; kk < 2; ++kk) { const bf16x8 bb = *(const LAS bf16x8*)(lds + GL_K + (dir * 64 + ni * 16 + fr) * 144 + kk * 64 + fq * 16); acc = mfma16(a[kk], bb, acc); }
#pragma unroll
          for (int i = 0; i < 4; ++i) { const int t = mi * 16 + fq * 4 + i, sidx = ni * 16 + fr; const bool keep = dir ? (sidx >= t) : (sidx <= t);
              *(LAS bf16_t*)(lds + GL_X + (dir * 64 + t) * 144 + sidx * 2) = f2bf(keep ? acc[i] : 0.f); } } }
    __syncthreads();
    LAS float* Ob = (LAS float*)lds;
    { const int mi = wave >> 1, nb = (wave & 1) * 3;
#pragma unroll
      for (int nn = 0; nn < 3; ++nn) { const int ni = nb + nn; f32x4 acc = (f32x4){0.f, 0.f, 0.f, 0.f};
#pragma unroll
          for (int dir = 0; dir < 2; ++dir)
#pragma unroll
              for (int kk = 0; kk < 2; ++kk) {
                  const bf16x8 a1 = *(const LAS bf16x8*)(lds + GL_X + (dir * 64 + mi * 16 + fr) * 144 + kk * 64 + fq * 16);
                  const bf16x8 b1 = *(const LAS bf16x8*)(lds + GL_VT + (ni * 16 + fr) * 144 + kk * 64 + fq * 16);
                  acc = mfma16(a1, b1, acc);
                  const bf16x8 a2 = *(const LAS bf16x8*)(lds + GL_Q + (dir * 64 + mi * 16 + fr) * 144 + kk * 64 + fq * 16);
                  const bf16x8 b2 = *(const LAS bf16x8*)(lds + GL_ST + (dir * 96 + ni * 16 + fr) * 144 + kk * 64 + fq * 16);
                  acc = mfma16(a2, b2, acc); }
#pragma unroll
          for (int i = 0; i < 4; ++i) Ob[(mi * 16 + fq * 4 + i) * 97 + ni * 16 + fr] = acc[i]; } }
    __syncthreads();
    { const int t = tf; float o[12]; float ss = 0.f;
#pragma unroll
      for (int e = 0; e < 12; ++e) { o[e] = Ob[t * 97 + part * 12 + e]; ss += o[e] * o[e]; }
      ss += shx(ss, 1, lane); ss += shx(ss, 2, lane); ss += shx(ss, 4, lane);
      const float rs = rsqrtf(ss * (1.0f / 96.0f) + 1e-6f);
      const float* gn = p.gla_o_norm + l * 96 + part * 12;
      bf16_t* yp = (bf16_t*)(p.ws + OFF_HY) + (size_t)(row0 + t) * 1024 + 640 + h * 96 + part * 12;
#pragma unroll
      for (int q4 = 0; q4 < 3; ++q4) { const u32x2 gw = ggw[q4]; float g[4] = {bflo(gw.x), bfhi(gw.x), bflo(gw.y), bfhi(gw.y)}; float r[4];
#pragma unroll
          for (int e = 0; e < 4; ++e) r[e] = o[q4 * 4 + e] * rs * gn[q4 * 4 + e] * (g[e] * __builtin_amdgcn_rcpf(1.f + __expf(-g[e])));
          u32x2 w; w.x = pk_bf16(r[0], r[1]); w.y = pk_bf16(r[2], r[3]); *(u32x2*)(yp + q4 * 4) = w; } }
}
__device__ __forceinline__ void gla_scan(int wv, const Params& p) {
    bf16_t* S = (bf16_t*)(p.ws + OFF_S); const float* DEC = (const float*)(p.ws + OFF_DEC);
    for (int e = blockIdx.x * 512 + otid(wv); e < 147456; e += gridDim.x * 512) {
        const int chain = e / 2304, idx = (e % 2304) * 2, dk = idx % 48, dir = chain & 1; const size_t base = (size_t)chain * 36;
        float s0 = 0.f, s1 = 0.f;
        for (int st0 = 0; st0 < 36; st0 += 6) { unsigned v[6]; float d0[6], d1[6]; unsigned* sp[6];
#pragma unroll
            for (int u = 0; u < 6; ++u) { const int st = st0 + u, n = dir ? 35 - st : (st < 4 ? 32 + st : st - 4); sp[u] = (unsigned*)(S + (base + n) * 4608 + idx); v[u] = *sp[u];
                const float* dp = DEC + (base + n) * 48 + dk; d0[u] = dp[0]; d1[u] = dp[1]; }
#pragma unroll
            for (int u = 0; u < 6; ++u) { *sp[u] = pk_bf16(s0, s1); s0 = s0 * d0[u] + bflo(v[u]); s1 = s1 * d1[u] + bfhi(v[u]); } }
    }
}

#define XB_TMO      128
#define XB_XCNT(j)  (256  + 64 * (j))
#define XB_XSUB(j)  (1280 + 64 * (j))
#define XB_XGEN(j)  (2304 + 64 * (j))
#define XB_TOP      3328
#define XB_TOPGEN   3392
#define XB_SPIN_CAP (1u << 22)
__device__ __forceinline__ unsigned xb_ld(unsigned* p)              { return __hip_atomic_load(p, __ATOMIC_RELAXED, __HIP_MEMORY_SCOPE_AGENT); }
__device__ __forceinline__ unsigned xb_add(unsigned* p, unsigned v) { return __hip_atomic_fetch_add(p, v, __ATOMIC_RELAXED, __HIP_MEMORY_SCOPE_AGENT); }
__device__ __forceinline__ unsigned xb_xcc_id() { return (unsigned)__builtin_amdgcn_s_getreg((3 << 11) | 20) & 0xFu; }
#define XB_SPIN(cond, bar) do { unsigned _sp = 0; while (cond) { __builtin_amdgcn_s_sleep(1); \
    if ((++_sp & 255u) == 0u) { if (xb_ld(&(bar)[XB_TMO])) break; if (_sp > XB_SPIN_CAP) { atomicAdd(&(bar)[XB_TMO], 1u); break; } } } } while (0)
__device__ __forceinline__ void xcd_barrier_complete(unsigned* bar, unsigned x, unsigned& nloc, unsigned& nx) {
    const unsigned G = gridDim.x;
    unsigned sum, cnt, mine, sp = 0u;
    for (;;) {
        sum = 0u; cnt = 0u; mine = 0u;
#pragma unroll
        for (unsigned j = 0; j < 16; ++j) { const unsigned c = xb_ld(&bar[XB_XCNT(j)]); sum += c; cnt += (c > 0u) ? 1u : 0u; mine = (j == x) ? c : mine; }
        if (sum == G) break;
        __builtin_amdgcn_s_sleep(1);
        if ((++sp & 255u) == 0u) { if (xb_ld(&bar[XB_TMO])) break; if (sp > XB_SPIN_CAP) { atomicAdd(&bar[XB_TMO], 1u); break; } }
    }
    nloc = mine > 0u ? mine : 1u; nx = cnt > 0u ? cnt : 1u;
}
__device__ __forceinline__ void grid_bar(int wv, unsigned* bar, volatile LAS unsigned* st) {
    asm volatile("s_waitcnt vmcnt(0)" ::: "memory");
    __syncthreads();
    if (otid(wv) == 0) {
        __builtin_amdgcn_s_waitcnt(0);
        const unsigned x = xb_xcc_id();
        unsigned nloc = st[0], nx = st[1];
        if (nloc == 0u) { xcd_barrier_complete(bar, x, nloc, nx); st[0] = nloc; st[1] = nx; }
        const unsigned old = xb_add(&bar[XB_XSUB(x)], 1u);
        const unsigned gen = old / nloc;
        if (old + 1u == (gen + 1u) * nloc) {
            __builtin_amdgcn_fence(__ATOMIC_RELEASE, "agent");
            asm volatile("s_waitcnt vmcnt(0)" ::: "memory");
            const unsigned og = xb_add(&bar[XB_TOP], 1u);
            const unsigned tg = og / nx;
            if (og + 1u == (tg + 1u) * nx) xb_add(&bar[XB_TOPGEN], 1u);
            else XB_SPIN(xb_ld(&bar[XB_TOPGEN]) == tg, bar);
            __builtin_amdgcn_fence(__ATOMIC_ACQUIRE, "agent");
            xb_add(&bar[XB_XGEN(x)], 1u);
            asm volatile("s_waitcnt vmcnt(0)" ::: "memory");
        } else {
            XB_SPIN(xb_ld(&bar[XB_XGEN(x)]) == gen, bar);
            __builtin_amdgcn_fence(__ATOMIC_ACQUIRE, "agent");
            asm volatile("s_waitcnt vmcnt(0)" ::: "memory");
        }
    }
    __syncthreads();
}

__global__ void __launch_bounds__(512, 2) hybrid_fwd(Params p_unused) {
    extern __shared__ __attribute__((aligned(16))) unsigned char smem[];
    LAS unsigned char* lds = (LAS unsigned char*)smem;
    const int wv = __builtin_amdgcn_readfirstlane((int)(threadIdx.x >> 6));
    const int G = gridDim.x, c = blockIdx.x;
    { volatile LAS unsigned* st = (volatile LAS unsigned*)(lds + QWORD_OFF + 4); const Params pb = ldp();
      if (otid(wv) == 0) { st[0] = 0u; st[1] = 0u; (void)xb_add((unsigned*)(pb.ws + OFF_BAR) + XB_XCNT(xb_xcc_id()), 1u); }
      __syncthreads(); }
#define GRID_SYNC() do { const Params pb = ldp(); grid_bar(wv, (unsigned*)(pb.ws + OFF_BAR), (volatile LAS unsigned*)(lds + QWORD_OFF + 4)); } while (0)

#ifndef PHM
#define PHM 0xFFFF
#endif
    if (PHM & 1) { const Params p = ldp(); phase0(wv, p, lds, c, G, 0, G == 256 ? 96 : 192, true); }
    GRID_SYNC();
#pragma nounroll
    for (int l = 0; l < 2; ++l) {
        const bool need_ctx = (l == 0);
        const int nM = need_ctx ? 72 : 64;
        if (PHM & 2) { const Params p = ldp(); phase_norm(wv, p, l, 0, MALL, l == 0 ? 0 : 5, (const float*)(p.ws + OFF_MOD) + (size_t)8 * 6144 + 5120); }
        { const Params p = ldp(); phase_weights(wv, p, l, lds, c, G); }
        GRID_SYNC();
        if (PHM & 8) { const Params p = ldp(); SchedInproj S{{need_ctx ? 792 : 768, G, c}, p.ws, need_ctx ? 0 : 1, (size_t)0 * WSET}; g8::EpiBf E; g8::gemm_phase(wv, lds, 1024, S, E); }
        if (l == 0) {
            const Params p = ldp(); if (G == 256) { if (c >= 48) trig_tables(wv, p, lds, c - 48, 208); } else trig_tables(wv, p, lds, c, G); }
        GRID_SYNC();
        { const Params p = ldp(); fourier_mid_row(wv, p); }
        if (PHM & 16) { const Params p = ldp(); SchedF1Lat S{{64, G, c}, p.ws}; g8::EpiBf E; g8::gemm_phase(wv, lds, 2048, S, E); }
        if ((PHM & 16) && need_ctx) { const Params p = ldp(); SchedF1Ctx S{{16, G, G - 1 - c}, p.ws}; g8::EpiBf E; g8::gemm_phase(wv, lds, 256, S, E); }
        { const int nNA = need_ctx ? 864 : 768, total = nNA + 1152;
          unsigned nxt_it = 0;
          const bool t0 = (otid(wv) == 0);
          if (t0) { const Params p = ldp(); nxt_it = atomicAdd((unsigned*)(p.ws + OFF_CTR) + l, 1u); }
          for (;;) {
              __syncthreads();
              if (t0) *(LAS unsigned*)(lds + QWORD_OFF) = nxt_it;
              __syncthreads();
              const int it = (int)*(LAS unsigned*)(lds + QWORD_OFF);
              if (it >= total) break;
              if (t0) { const Params p = ldp(); nxt_it = atomicAdd((unsigned*)(p.ws + OFF_CTR) + l, 1u); }
              if (it < nNA) { if (PHM & 32) { const Params p = ldp(); na_item(wv, p, l, it, lds); } } else { if (PHM & 64) { const Params p = ldp(); gla_g1_item(wv, p, l, it - nNA, lds); } }
          } }
        GRID_SYNC();
        if (PHM & 256) { const Params p = ldp(); gla_scan(wv, p); }
        GRID_SYNC();
        if (PHM & 128) { const Params p = ldp(); SchedF2 S{{nM, G, c}, p.ws, (size_t)0 * WSET}; g8::EpiBf E; g8::gemm_phase(wv, lds, 512, S, E); }
        { const int nch = need_ctx ? 36 : 32, nit = 8 * nch * 4;
          unsigned nxt_it = 0; const bool t0 = (otid(wv) == 0);
          if (t0) { const Params p = ldp(); nxt_it = atomicAdd((unsigned*)(p.ws + OFF_CTR) + 2 + l, 1u); }
          for (;;) {
              __syncthreads();
              if (t0) *(LAS unsigned*)(lds + QWORD_OFF) = nxt_it;
              __syncthreads();
              const int it = (int)*(LAS unsigned*)(lds + QWORD_OFF);
              if (it >= nit) break;
              if (t0) { const Params p = ldp(); nxt_it = atomicAdd((unsigned*)(p.ws + OFF_CTR) + 2 + l, 1u); }
              const int b = it / (nch * 4), rem = it % (nch * 4);
              if (PHM & 512) { const Params p = ldp(); gla_g3_item(wv, p, l, b, rem >> 2, rem & 3, lds); }
          } }
        GRID_SYNC();
        if (PHM & 1024) { const Params p = ldp(); const float* mod = (const float*)(p.ws + OFF_MOD); SchedRes S{G, c, need_ctx ? 1 : 0, 4, 16, 4, p.ws, (const char*)(p.ws + OFF_HY), (size_t)256 * 2048, (const char*)(p.ws + OFF_WOUT + (size_t)0 * WSET), (size_t)256 * 2048,
                     l == 0 ? (const void*)p.x : (const void*)(p.ws + OFF_XB), (void*)(p.ws + OFF_XB), l == 0 ? 2 : 3, mod + (size_t)l * 9 * 6144 + 2048};
          g8::EpiRes E; g8::gemm_phase(wv, lds, 1024, S, E); }
        GRID_SYNC();
        if (PHM & 2048) { const Params p = ldp(); phase_norm(wv, p, l, 1, nM * 256, 4, (const float*)(p.ws + OFF_MOD) + (size_t)(l * 9 + 8) * 6144 + 2048); }
        GRID_SYNC();
        if (PHM & 4096) { const Params p = ldp(); SchedFfn1 S{{nM * 22, G, c}, p.ws, (size_t)0 * WSET}; g8::EpiSwiglu E; g8::gemm_phase(wv, lds, 1024, S, E); }
        if (l == 0 && G == 256 && c >= 96) { const Params p = ldp(); phase0(wv, p, lds, c - 96, 160, 96, 192, false); }
        GRID_SYNC();
        if (PHM & 8192) { const Params p = ldp(); const float* mod = (const float*)(p.ws + OFF_MOD); SchedRes S{G, c, need_ctx ? 1 : 0, 5, 44, 8, p.ws, (const char*)(p.ws + OFF_U), (size_t)256 * DFF * 2, (const char*)(p.ws + OFF_W2 + (size_t)0 * WSET), (size_t)256 * DFF * 2,
                     (const void*)(p.ws + OFF_XB), l == 0 ? (void*)(p.ws + OFF_XB) : (void*)p.out, l == 0 ? 3 : 1, mod + (size_t)l * 9 * 6144 + 5120};
          g8::EpiRes E; g8::gemm_phase(wv, lds, DFF, S, E); }
        if (l == 0) GRID_SYNC();
    }
}

extern "C" void kernel_launch(void* const* d_in, const int* in_sizes, int n_in, void* d_out, int out_size, void* d_ws, size_t ws_size, hipStream_t stream) {
    static int grid_blocks = 0;
    if (!grid_blocks) {
        int dev = 0, cus = 0, per_cu = 0;
        (void)hipGetDevice(&dev);
        (void)hipDeviceGetAttribute(&cus, hipDeviceAttributeMultiprocessorCount, dev);
        if (hipFuncSetAttribute((const void*)hybrid_fwd, hipFuncAttributeMaxDynamicSharedMemorySize, LDS_BYTES) != hipSuccess) fprintf(stderr, "hipFuncSetAttribute failed\n");
        if (hipOccupancyMaxActiveBlocksPerMultiprocessor(&per_cu, (const void*)hybrid_fwd, 512, LDS_BYTES) != hipSuccess || per_cu < 1) { fprintf(stderr, "occupancy query: %d\n", per_cu); }
        (void)hipGetLastError();
        grid_blocks = cus > 0 ? cus : 256;
        if (ws_size < WS_END) fprintf(stderr, "workspace too small: %zu < %zu\n", ws_size, (size_t)WS_END);
    }
    Params p{};
    const float** f = (const float**)&p;
    for (int i = 0; i < 20; ++i) f[i] = (const float*)d_in[i];
    p.out = (float*)d_out; p.ws = (unsigned char*)d_ws;
    (void)hipMemsetAsync((unsigned char*)d_ws + OFF_CTR, 0, 256 + 13824, stream);
    void* args[] = {&p};
    hipError_t e = hipLaunchCooperativeKernel((void*)hybrid_fwd, dim3(grid_blocks), dim3(512), args, LDS_BYTES, stream);
    if (e != hipSuccess) fprintf(stderr, "cooperative launch failed: %s (grid %d)\n", hipGetErrorString(e), grid_blocks);
}
```

```cpp
#include <hip/hip_runtime.h>
#include <hip/hip_cooperative_groups.h>
#include <cstdio>
namespace cg = cooperative_groups;

#define LAS __attribute__((address_space(3)))
typedef unsigned short bf16_t;
typedef short bf16x8 __attribute__((ext_vector_type(8)));
typedef float f32x4 __attribute__((ext_vector_type(4)));
typedef unsigned u32x4 __attribute__((ext_vector_type(4)));
typedef unsigned u32x2 __attribute__((ext_vector_type(2)));

constexpr int DM = 1024, MLAT = 16384, MALL = 18432, DFF = 2816, NINW = 2592;
constexpr int ZLD = 1568;
constexpr int ZC_NK = 384, ZC_GQ = 768, ZC_GK = 960, ZC_GG = 1152, ZC_GA = 1536;
constexpr int TC_NV = 256, TC_GV = 640;
constexpr float LOG2E = 1.4426950408889634f;
constexpr int LDS_BYTES = 147456;
constexpr int QWORD_OFF = LDS_BYTES - 16;

constexpr size_t OFF_XCTX = 0;
constexpr size_t OFF_HY   = OFF_XCTX + (size_t)2048 * 1024 * 4;
constexpr size_t OFF_Z    = OFF_HY + (size_t)MALL * 1024 * 2;
constexpr size_t OFF_TLAT = OFF_Z + (size_t)MALL * ZLD * 2;
constexpr size_t OFF_TCTX = OFF_TLAT + (size_t)8 * 1024 * 2048 * 2;
constexpr size_t OFF_PQ   = OFF_TCTX + (size_t)8 * 1024 * 256 * 2;
constexpr size_t OFF_S    = OFF_PQ + (size_t)MALL * 512 * 2;
constexpr size_t OFF_U    = OFF_Z;
static_assert((size_t)MALL * DFF * 2 <= OFF_S - OFF_Z, "U alias");
constexpr size_t OFF_DEC  = OFF_S + (size_t)2304 * 4608 * 2;
constexpr size_t OFF_WSW  = OFF_DEC + (size_t)2304 * 48 * 4;
constexpr size_t OFF_WZ   = OFF_WSW + (size_t)1024 * 1024 * 2;
constexpr size_t OFF_W13  = OFF_WZ + (size_t)1792 * 1024 * 2;
constexpr size_t OFF_WOUT = OFF_W13 + (size_t)5632 * 1024 * 2;
constexpr size_t OFF_W2   = OFF_WOUT + (size_t)1024 * 1024 * 2;
constexpr size_t OFF_WF   = OFF_W2 + (size_t)1024 * 2816 * 2;
constexpr size_t WSET     = OFF_WF + (size_t)256 * 512 * 2 - OFF_WSW;
constexpr size_t OFF_XB   = OFF_WSW + WSET;
constexpr size_t OFF_TL   = OFF_XB + (size_t)MALL * 1024 * 2;
constexpr size_t OFF_TC   = OFF_TL + (size_t)4096 * 2048 * 2;
constexpr size_t OFF_MOD  = OFF_TC + (size_t)512 * 256 * 2;
constexpr size_t OFF_ROPE = OFF_MOD + (size_t)2 * 9 * 6144 * 4;
constexpr size_t OFF_CTR  = OFF_ROPE + 64 * 12 * 8;
constexpr size_t OFF_BAR  = OFF_CTR + 256;
constexpr size_t WS_END   = OFF_BAR + 13824;
static_assert(WS_END <= (size_t)256 * 1024 * 1024, "workspace");

struct Params {
    const float *x, *c, *ctx, *c_ctx, *ada_w, *ada_b, *norm_mix, *norm_ffn, *w_in, *fnet_w, *na_q_norm, *na_k_norm, *na_rpb,
        *gla_alpha_w, *gla_alpha_b, *gla_o_norm, *w_out, *ffn_w1, *ffn_w3, *ffn_w2;
    float* out; unsigned char* ws;
};
__device__ __forceinline__ Params ldp() {
#if defined(__HIP_DEVICE_COMPILE__)
    typedef const __attribute__((address_space(4))) unsigned long long* kptr;
    kptr kp = (kptr)__builtin_amdgcn_kernarg_segment_ptr(); asm volatile("" : "+s"(kp));
    Params r; unsigned long long* d = (unsigned long long*)&r;
#pragma unroll
    for (int i = 0; i < 22; ++i) d[i] = (unsigned long long)(float*)(__attribute__((address_space(1))) float*)kp[i];
    return r;
#else
    return Params{};
#endif
}

__device__ __forceinline__ unsigned pk_bf16(float lo, float hi) { unsigned r; asm volatile("v_cvt_pk_bf16_f32 %0, %1, %2" : "=v"(r) : "v"(lo), "v"(hi)); return r; }
__device__ __forceinline__ bf16_t f2bf(float f) { unsigned u = __float_as_uint(f); u += 0x7FFFu + ((u >> 16) & 1u); return (bf16_t)(u >> 16); }
__device__ __forceinline__ float bf2f(bf16_t h) { return __uint_as_float(((unsigned)h) << 16); }
__device__ __forceinline__ float bflo(unsigned w) { return __uint_as_float(w << 16); }
__device__ __forceinline__ float bfhi(unsigned w) { return __uint_as_float(w & 0xffff0000u); }
__device__ __forceinline__ f32x4 mfma16(bf16x8 a, bf16x8 b, f32x4 c) { return __builtin_amdgcn_mfma_f32_16x16x32_bf16(a, b, c, 0, 0, 0); }
__device__ __forceinline__ bf16x8 as_bf8(u32x4 w) { return __builtin_bit_cast(bf16x8, w); }
__device__ __forceinline__ void st16_wt(void* p, u32x4 v) { *(u32x4*)p = v; }
__device__ __forceinline__ int otid(int wv) { int ln; asm volatile("v_mbcnt_lo_u32_b32 %0, -1, 0\n\tv_mbcnt_hi_u32_b32 %0, -1, %0" : "=v"(ln)); return wv * 64 + ln; }
__device__ __forceinline__ float shx(float v, int m, int lane) { return __int_as_float(__builtin_amdgcn_ds_bpermute((lane ^ m) << 2, __float_as_int(v))); }

__device__ __forceinline__ float xmax16(float v) { const auto r = __builtin_amdgcn_permlane16_swap(__float_as_uint(v), __float_as_uint(v), false, false); return fmaxf(__uint_as_float(r[0]), __uint_as_float(r[1])); }
__device__ __forceinline__ float xmax32(float v) { const auto r = __builtin_amdgcn_permlane32_swap(__float_as_uint(v), __float_as_uint(v), false, false); return fmaxf(__uint_as_float(r[0]), __uint_as_float(r[1])); }
__device__ __forceinline__ float xsum16(float v) { const auto r = __builtin_amdgcn_permlane16_swap(__float_as_uint(v), __float_as_uint(v), false, false); return __uint_as_float(r[0]) + __uint_as_float(r[1]); }
__device__ __forceinline__ float xsum32(float v) { const auto r = __builtin_amdgcn_permlane32_swap(__float_as_uint(v), __float_as_uint(v), false, false); return __uint_as_float(r[0]) + __uint_as_float(r[1]); }

namespace g8 {
constexpr int BM = 256, BK = 64, HALF = 128, HTB = HALF * BK * 2;
__device__ __forceinline__ int lds_byte(int r, int c) { const int st = (r >> 4) * 2 + (c >> 5), rr = r & 15, cc = c & 31, ob = rr * 64 + cc * 2; return st * 1024 + (ob ^ (((ob >> 9) & 1) << 5)); }
__device__ __forceinline__ void stage_rc(int b, int& R, int& C) { const int st = b / 1024, sb = b % 1024, swz = sb ^ (((sb >> 9) & 1) << 5); R = (st >> 1) * 16 + swz / 64; C = (st & 1) * 32 + (swz % 64) / 2; }
__device__ __forceinline__ int perm32(int rho) { const int n = rho >> 4, i = rho & 15; return 8 * (i >> 2) + 4 * n + (i & 3); }

struct Unit { const char* a; const char* b; char* o; const float* p1; const float* p2; int ldo; int cmax; int nt; int mode; int half; int mk; int mneg; };

struct ListOrder {
    int n, G, c;
    __device__ __forceinline__ bool idx(int i, int& Lp) const {
        const long L = (long)i * G + c; if (L >= n) return false;
        const int w = (int)L, q = n / 8, r = n % 8, xcd = w % 8, off = w / 8;
        Lp = (xcd < r ? xcd * (q + 1) : r * (q + 1) + (xcd - r) * q) + off; return true;
    }
};

struct ListOrderH {
    int n, G, c;
    __device__ __forceinline__ bool idx(int i, int& Lp, int& half) const {
        const int R = n / G, T = n % G; long L; half = 0;
        if (i == R && T > 0 && 2 * T <= G) { if (c >= 2 * T) return false; L = (long)R * G + (c >> 1); half = 1 + (c & 1); }
        else { L = (long)i * G + c; if (L >= n) return false; }
        const int w = (int)L, q = n / 8, r = n % 8, xcd = w % 8, off = w / 8;
        Lp = (xcd < r ? xcd * (q + 1) : r * (q + 1) + (xcd - r) * q) + off; return true;
    }
};

template <class Epi, class Sched>
__device__ __forceinline__ void gemm_phase(int wv, LAS unsigned char* lds, const int K, const Sched& S, const Epi& E) {
    const int tid = otid(wv), wid = __builtin_amdgcn_readfirstlane(tid >> 6), lane = tid & 63, wr = wid >> 2, wc = wid & 3, fr = lane & 15, fq = lane >> 4;
    unsigned voffA[2], voffB[2];
#pragma unroll
    for (int i = 0; i < 2; ++i) { int R, C; stage_rc(tid * 16 + i * 8192, R, C); const int Rb = Epi::PERM ? ((R & ~31) + perm32(R & 31)) : R;
        voffA[i] = (unsigned)(R * K + C) * 2u; voffB[i] = (unsigned)(Rb * K + C) * 2u; }
    const size_t kstep = (size_t)(BK * 2);
    const size_t hstep = (size_t)HALF * K * 2;
    const unsigned ldsw = (unsigned)wid * 1024u;
    const int aoff = lds_byte(wr * 64 + fr, fq * 8), boff = lds_byte(wc * 32 + fr, fq * 8);
#define G8_SA(b, h) (((b) * 2 + (h)) * HTB)
#define G8_SB(b, h) ((4 + (b) * 2 + (h)) * HTB)
#define G8_STAGE(bufoff, gbase, voff) do { _Pragma("unroll") for (int _i = 0; _i < 2; ++_i) \
        __builtin_amdgcn_global_load_lds((const unsigned*)((const char*)(gbase) + (voff)[_i]), (LAS unsigned*)(lds + (bufoff) + ldsw + _i * 8192), 16, 0, 0); } while (0)
#define G8_LDA(dst, b, h) do { _Pragma("unroll") for (int m = 0; m < 4; ++m) _Pragma("unroll") for (int k = 0; k < 2; ++k) dst[m][k] = *(const LAS bf16x8*)(lds + G8_SA(b, h) + aoff + m * 2048 + k * 1024); } while (0)
#define G8_LDB(dst, b, h) do { _Pragma("unroll") for (int n = 0; n < 2; ++n) _Pragma("unroll") for (int k = 0; k < 2; ++k) dst[n][k] = *(const LAS bf16x8*)(lds + G8_SB(b, h) + boff + n * 2048 + k * 1024); } while (0)
#define G8_MMA(ai, bj, At, Bt) do { __builtin_amdgcn_s_setprio(1); _Pragma("unroll") for (int m = 0; m < 4; ++m) _Pragma("unroll") for (int n = 0; n < 2; ++n) _Pragma("unroll") for (int k = 0; k < 2; ++k) \
        acc[ai][bj][m][n] = __builtin_amdgcn_mfma_f32_16x16x32_bf16(Bt[n][k], At[m][k], acc[ai][bj][m][n], 0, 0, 0); __builtin_amdgcn_s_setprio(0); } while (0)
#define G8_WAIT_V(n) asm volatile("s_waitcnt vmcnt(" #n ")" ::: "memory")
#define G8_WAIT_L(n) asm volatile("s_waitcnt lgkmcnt(" #n ")" ::: "memory")
#define G8_BAR __builtin_amdgcn_s_barrier()
#define G8_SCHED __builtin_amdgcn_sched_barrier(0)
    Unit cur, nxt; int ui = 0;
    if (!S.next(0, cur)) return;
    f32x4 acc[2][2][4][2];
#pragma unroll
    for (int a = 0; a < 2; ++a)
#pragma unroll
        for (int b = 0; b < 2; ++b)
#pragma unroll
            for (int m = 0; m < 4; ++m)
#pragma unroll
                for (int n = 0; n < 2; ++n) acc[a][b][m][n] = (f32x4){0.f, 0.f, 0.f, 0.f};
    bf16x8 At[4][2], B0[2][2], B1[2][2];
    const char* cA = cur.a; const char* cB = cur.b;
    G8_STAGE(G8_SB(0, 0), cB, voffB); G8_STAGE(G8_SA(0, 0), cA, voffA); G8_STAGE(G8_SB(0, 1), cB + hstep, voffB); G8_STAGE(G8_SA(0, 1), cA + hstep, voffA);
    if (wr == 1) G8_BAR;
    G8_WAIT_V(4); G8_BAR;
    G8_STAGE(G8_SB(1, 0), cB + kstep, voffB); G8_STAGE(G8_SA(1, 0), cA + kstep, voffA); G8_STAGE(G8_SB(1, 1), cB + hstep + kstep, voffB);
    G8_WAIT_V(6); G8_BAR;
    for (;;) {
        const bool has_next = S.next(ui + 1, nxt);
        const char* nA = has_next ? nxt.a : cA; const char* nB = has_next ? nxt.b : cB;
        const int nt = cur.nt; const bool full = (cur.half == 0);
        for (int t = 0; t < nt; t += 2) {
            const bool last = (t == nt - 2);
            const char* a1 = cA + (size_t)(t + 1) * kstep;
            const char* a2 = last ? nA : cA + (size_t)(t + 2) * kstep; const char* b2 = last ? nB : cB + (size_t)(t + 2) * kstep;
            const char* a3 = a2 + kstep; const char* b3 = b2 + kstep;
            G8_LDB(B0, 0, 0); G8_SCHED; G8_LDA(At, 0, 0); G8_STAGE(G8_SA(1, 1), a1 + hstep, voffA);
            G8_WAIT_L(8); G8_BAR; G8_WAIT_L(0); G8_MMA(0, 0, At, B0); G8_BAR; G8_SCHED;
            G8_LDB(B1, 0, 1); G8_STAGE(G8_SB(0, 0), b2, voffB);
            G8_BAR; G8_WAIT_L(0); G8_MMA(0, 1, At, B1); G8_BAR;
            if (full) G8_LDA(At, 0, 1); G8_STAGE(G8_SA(0, 0), a2, voffA);
            G8_BAR; G8_WAIT_L(0); if (full) G8_MMA(1, 0, At, B0); G8_BAR; G8_SCHED;
            G8_STAGE(G8_SB(0, 1), b2 + hstep, voffB);
            G8_WAIT_V(6); G8_BAR; if (full) G8_MMA(1, 1, At, B1); G8_BAR;
            G8_LDB(B0, 1, 0); G8_SCHED; G8_LDA(At, 1, 0); G8_STAGE(G8_SA(0, 1), a2 + hstep, voffA);
            G8_WAIT_L(8); G8_BAR; G8_WAIT_L(0); G8_MMA(0, 0, At, B0); G8_BAR; G8_SCHED;
            G8_LDB(B1, 1, 1); G8_STAGE(G8_SB(1, 0), b3, voffB);
            G8_BAR; G8_WAIT_L(0); G8_MMA(0, 1, At, B1); G8_BAR;
            if (full) G8_LDA(At, 1, 1); G8_STAGE(G8_SA(1, 0), a3, voffA);
            G8_BAR; G8_WAIT_L(0); if (full) G8_MMA(1, 0, At, B0); G8_BAR; G8_SCHED;
            G8_STAGE(G8_SB(1, 1), b3 + hstep, voffB);
            G8_WAIT_V(6); G8_BAR; if (full) G8_MMA(1, 1, At, B1); G8_BAR;
        }
        { const int t2 = otid(wv); E(acc, cur, wr, wc, t2 & 15, (t2 >> 4) & 3); }
        if (!has_next) break;
#pragma unroll
        for (int a = 0; a < 2; ++a)
#pragma unroll
            for (int b = 0; b < 2; ++b)
#pragma unroll
                for (int m = 0; m < 4; ++m)
#pragma unroll
                    for (int n = 0; n < 2; ++n) acc[a][b][m][n] = (f32x4){0.f, 0.f, 0.f, 0.f};
        cur = nxt; cA = nA; cB = nB; ++ui;
    }
    G8_WAIT_V(0);
    if (wr == 0) G8_BAR;
    G8_BAR;
#undef G8_SA
#undef G8_SB
#undef G8_STAGE
#undef G8_LDA
#undef G8_LDB
#undef G8_MMA
#undef G8_WAIT_V
#undef G8_WAIT_L
#undef G8_BAR
#undef G8_SCHED
}

struct EpiBf {
    static constexpr bool PERM = true;
    __device__ __forceinline__ void operator()(const f32x4 (&acc)[2][2][4][2], const Unit& u, int wr, int wc, int fr, int fq) const {
        const int row0 = wr * 64 + fr, col0 = wc * 32 + 8 * fq;
#pragma unroll
        for (int ai = 0; ai < 2; ++ai) if (ai == 0 || u.half == 0)
#pragma unroll
            for (int m = 0; m < 4; ++m) { const int rr = row0 + ai * HALF + m * 16; bf16_t* rowp = (bf16_t*)u.o + (size_t)rr * u.ldo + col0;
                const int k = u.mk + rr; const bool mir = (u.mk >= 0) && (k > 0);
                bf16_t* rowm = (bf16_t*)u.p1 + (size_t)(2048 - k) * u.ldo + col0;
#pragma unroll
                for (int bj = 0; bj < 2; ++bj) { if (col0 + bj * HALF < u.cmax) { const f32x4 v0 = acc[ai][bj][m][0], v1 = acc[ai][bj][m][1];
                    u32x4 w; w.x = pk_bf16(v0[0], v0[1]); w.y = pk_bf16(v0[2], v0[3]); w.z = pk_bf16(v1[0], v1[1]); w.w = pk_bf16(v1[2], v1[3]);
                    st16_wt(rowp + bj * HALF, w);
                    if (mir) { const float sg = u.mneg ? -1.f : 1.f; u32x4 w2; w2.x = pk_bf16(v0[0] * sg, v0[1] * sg); w2.y = pk_bf16(v0[2] * sg, v0[3] * sg); w2.z = pk_bf16(v1[0] * sg, v1[1] * sg); w2.w = pk_bf16(v1[2] * sg, v1[3] * sg);
                        st16_wt(rowm + bj * HALF, w2); } } } }
    }
};
struct EpiRes {
    static constexpr bool PERM = true;
    __device__ __forceinline__ void operator()(const f32x4 (&acc)[2][2][4][2], const Unit& u, int wr, int wc, int fr, int fq) const {
        const int row0 = wr * 64 + fr, col0 = wc * 32 + 8 * fq;
        if (u.mode == 0) {
            f32x4 gv[2][2];
#pragma unroll
            for (int bj = 0; bj < 2; ++bj)
#pragma unroll
                for (int n = 0; n < 2; ++n) gv[bj][n] = *(const f32x4*)(u.p2 + col0 + bj * HALF + n * 4);
            const bool bb16 = (u.cmax & 1) != 0, ob16 = (u.cmax & 2) != 0;
            f32x4 bs[2][2][2];
#define RES_LOAD(BUF, OFF) do { _Pragma("unroll") for (int bj = 0; bj < 2; ++bj) { \
                if (bb16) { const u32x4 w = *(const u32x4*)((const bf16_t*)u.p1 + (OFF) + bj * HALF); bs[BUF][bj][0] = (f32x4){bflo(w.x), bfhi(w.x), bflo(w.y), bfhi(w.y)}; bs[BUF][bj][1] = (f32x4){bflo(w.z), bfhi(w.z), bflo(w.w), bfhi(w.w)}; } \
                else { bs[BUF][bj][0] = *(const f32x4*)(u.p1 + (OFF) + bj * HALF); bs[BUF][bj][1] = *(const f32x4*)(u.p1 + (OFF) + bj * HALF + 4); } } } while (0)
            RES_LOAD(0, (size_t)row0 * 1024 + col0);
#pragma unroll
            for (int g = 0; g < 8; ++g) { const int ai = g >> 2, m = g & 3; const size_t off = (size_t)(row0 + ai * HALF + m * 16) * 1024 + col0;
                if (g < 7) { const int ai2 = (g + 1) >> 2, m2 = (g + 1) & 3; const size_t off2 = (size_t)(row0 + ai2 * HALF + m2 * 16) * 1024 + col0;
                    if (g & 1) { RES_LOAD(0, off2); } else { RES_LOAD(1, off2); } }
                asm volatile("" ::: "memory");
#pragma unroll
                for (int bj = 0; bj < 2; ++bj) { const f32x4 x0 = bs[g & 1][bj][0] + gv[bj][0] * acc[ai][bj][m][0], x1 = bs[g & 1][bj][1] + gv[bj][1] * acc[ai][bj][m][1];
                    if (ob16) { u32x4 w; w.x = pk_bf16(x0[0], x0[1]); w.y = pk_bf16(x0[2], x0[3]); w.z = pk_bf16(x1[0], x1[1]); w.w = pk_bf16(x1[2], x1[3]); st16_wt((bf16_t*)u.o + off + bj * HALF, w); }
                    else { st16_wt((float*)u.o + off + bj * HALF, __builtin_bit_cast(u32x4, x0)); st16_wt((float*)u.o + off + bj * HALF + 4, __builtin_bit_cast(u32x4, x1)); } }
                asm volatile("" ::: "memory"); }
#undef RES_LOAD
        } else {
#pragma unroll
            for (int ai = 0; ai < 2; ++ai)
#pragma unroll
                for (int m = 0; m < 4; ++m) { bf16_t* op = (bf16_t*)u.o + (size_t)(row0 + ai * HALF + m * 16) * 1024 + col0;
#pragma unroll
                    for (int bj = 0; bj < 2; ++bj) { const f32x4 v0 = acc[ai][bj][m][0], v1 = acc[ai][bj][m][1];
                        u32x4 w; w.x = pk_bf16(v0[0], v0[1]); w.y = pk_bf16(v0[2], v0[3]); w.z = pk_bf16(v1[0], v1[1]); w.w = pk_bf16(v1[2], v1[3]); st16_wt(op + bj * HALF, w); } }
        }
    }
};
struct EpiSwiglu {
    static constexpr bool PERM = false;
    __device__ __forceinline__ void operator()(const f32x4 (&acc)[2][2][4][2], const Unit& u, int wr, int wc, int fr, int fq) const {
        const int row0 = wr * 64 + fr, col0 = wc * 32 + 8 * fq;
#pragma unroll
        for (int ai = 0; ai < 2; ++ai) if (ai == 0 || u.half == 0)
#pragma unroll
            for (int m = 0; m < 4; ++m) { bf16_t* rowp = (bf16_t*)u.o + (size_t)(row0 + ai * HALF + m * 16) * u.ldo + col0; float r[8];
#pragma unroll
                for (int bj = 0; bj < 2; ++bj) { const f32x4 a = acc[ai][bj][m][0], b = acc[ai][bj][m][1];
#pragma unroll
                    for (int e = 0; e < 4; ++e) r[bj * 4 + e] = a[e] * b[e] * __builtin_amdgcn_rcpf(1.f + __expf(-a[e])); }
                u32x4 w; w.x = pk_bf16(r[0], r[1]); w.y = pk_bf16(r[2], r[3]); w.z = pk_bf16(r[4], r[5]); w.w = pk_bf16(r[6], r[7]); st16_wt(rowp, w); }
    }
};
}
using g8::Unit;

struct SchedInproj {
    g8::ListOrderH L; unsigned char* ws; int l1; size_t wo;
    __device__ __forceinline__ bool next(int i, Unit& u) const {
        int q, hf; if (!L.idx(i, q, hf)) return false;
        const char* H = (const char*)(ws + OFF_HY);
        u.p1 = nullptr; u.p2 = nullptr; u.nt = 16; u.mode = 0; u.half = 0; u.mk = -1; u.mneg = 0;
        int kind, pm, pn, bt = 0;
        if (!l1) { if (q < 504) { kind = 0; const int gid = q / 56, rem = q % 56; pm = gid * 8 + (rem & 7); pn = rem >> 3; } else if (q < 760) { const int s = q - 504; kind = 1; bt = s >> 5; pn = (s & 31) >> 2; pm = s & 3; } else { const int s = q - 760; kind = 2; bt = s >> 2; pm = s & 3; pn = 0; } }
        else { if (q < 448) { kind = 0; const int gid = q / 56, rem = q % 56; pm = gid * 8 + (rem & 7); pn = rem >> 3; } else if (q < 488) { const int s = q - 448, r5 = s % 5; kind = 0; pm = 64 + s / 5; pn = r5 < 4 ? r5 + 1 : 6; }
               else if (q < 744) { const int s = q - 488; kind = 1; bt = s >> 5; pn = (s & 31) >> 2; pm = s & 3; } else { const int s = q - 744; kind = 2; bt = s / 3; pm = 1 + s % 3; pn = 0; } }
        if (kind == 0) {
            u.a = H + (size_t)pm * 256 * 2048; u.b = (const char*)(ws + OFF_WZ + wo) + (size_t)pn * 256 * 2048;
            u.o = (char*)(ws + OFF_Z) + ((size_t)pm * 256 * ZLD + pn * 256) * 2; u.ldo = ZLD; u.cmax = ZLD - pn * 256;
        } else if (kind == 1) {
            u.a = (const char*)(ws + OFF_WSW + wo) + (size_t)pm * 256 * 2048; u.b = H + ((size_t)bt * 2048 + pn * 256) * 2048;
            u.o = (char*)(ws + OFF_TLAT) + (((size_t)bt * 1024 + pm * 256) * 2048 + pn * 256) * 2; u.ldo = 2048; u.cmax = 256;
        } else {
            u.a = (const char*)(ws + OFF_WSW + wo) + (size_t)pm * 256 * 2048; u.b = H + ((size_t)MLAT + bt * 256) * 2048;
            u.o = (char*)(ws + OFF_TCTX) + (((size_t)bt * 1024 + pm * 256) * 256) * 2; u.ldo = 256; u.cmax = 256; }
        if (hf) { u.half = 1; if (hf == 2) { u.a += (size_t)128 * 2048; u.o += (size_t)128 * u.ldo * 2; } }
        return true;
    }
};
struct SchedF1Lat {
    g8::ListOrder L; unsigned char* ws;
    __device__ __forceinline__ bool next(int i, Unit& u) const {
        int q; if (!L.idx(i, q)) return false;
        const int bt = q >> 3, isq = (q >> 2) & 1, pm = q & 3;
        u.a = (const char*)(ws + OFF_TL) + (size_t)(isq * 8 + pm) * 256 * 4096; u.b = (const char*)(ws + OFF_TLAT) + (size_t)bt * 1024 * 4096;
        u.o = (char*)(ws + OFF_PQ) + (((size_t)bt * 2048 + pm * 256) * 512 + isq * 256) * 2; u.ldo = 512; u.cmax = 256; u.p2 = nullptr; u.nt = 32; u.mode = 0; u.half = 0;
        u.p1 = (const float*)((bf16_t*)(ws + OFF_PQ) + ((size_t)bt * 2048) * 512 + isq * 256); u.mk = pm * 256; u.mneg = isq;
        return true;
    }
};
__device__ __forceinline__ void fourier_mid_row(int wv, const Params& p) {
    const int tid = otid(wv), lane = tid & 63, gw = blockIdx.x * 8 + (tid >> 6), nw = gridDim.x * 8;
    const bf16_t* TLAT = (const bf16_t*)(p.ws + OFF_TLAT); bf16_t* PQ = (bf16_t*)(p.ws + OFF_PQ);
    for (int pr = gw; pr < 2048; pr += nw) { const int bt = pr >> 8, ch = pr & 255;
        const bf16_t* src = TLAT + ((size_t)bt * 1024 + ch) * 2048 + lane * 32; float acc = 0.f;
#pragma unroll
        for (int j = 0; j < 4; ++j) { const u32x4 w = *(const u32x4*)(src + j * 8);
            acc += (bflo(w.x) - bfhi(w.x)) + (bflo(w.y) - bfhi(w.y)) + (bflo(w.z) - bfhi(w.z)) + (bflo(w.w) - bfhi(w.w)); }
#pragma unroll
        for (int o = 32; o >= 1; o >>= 1) acc += shx(acc, o, lane);
        if (lane == 0) { PQ[((size_t)bt * 2048 + 1024) * 512 + ch] = f2bf(acc * 0.022097086912079608f); PQ[((size_t)bt * 2048 + 1024) * 512 + 256 + ch] = 0; } }
}
struct SchedF1Ctx {
    g8::ListOrder L; unsigned char* ws;
    __device__ __forceinline__ bool next(int i, Unit& u) const {
        int q; if (!L.idx(i, q)) return false;
        const int bt = q >> 1, pm = q & 1;
        u.a = (const char*)(ws + OFF_TC) + (size_t)pm * 256 * 512; u.b = (const char*)(ws + OFF_TCTX) + (size_t)bt * 1024 * 512;
        u.o = (char*)(ws + OFF_PQ) + (((size_t)MLAT + bt * 256) * 512 + pm * 256) * 2; u.ldo = 512; u.cmax = 256; u.p1 = nullptr; u.p2 = nullptr; u.nt = 4; u.mode = 0; u.half = 0; u.mk = -1; u.mneg = 0;
        return true;
    }
};
struct SchedF2 {
    g8::ListOrder L; unsigned char* ws; size_t wo;
    __device__ __forceinline__ bool next(int i, Unit& u) const {
        int q; if (!L.idx(i, q)) return false;
        u.a = (const char*)(ws + OFF_PQ) + (size_t)q * 256 * 1024; u.b = (const char*)(ws + OFF_WF + wo);
        u.o = (char*)(ws + OFF_HY) + (size_t)q * 256 * 2048; u.ldo = 1024; u.cmax = 256; u.p1 = nullptr; u.p2 = nullptr; u.nt = 8; u.mode = 0; u.half = 0; u.mk = -1; u.mneg = 0;
        return true;
    }
};
struct SchedRes {
    int G, c, with_ctx, nsp, ntk, ntp;
    unsigned char* ws; const char* A; size_t a_tile_bytes; const char* Bt; size_t b_tile_bytes;
    const void* base_lat; void* out_lat; int flags; const float* gate;
    __device__ __forceinline__ bool next(int i, Unit& u) const {
        u.ldo = 1024; u.cmax = flags;
        const int r0 = (256 + G - 1) / G;
        if (i < r0) { g8::ListOrder L{256, G, c}; int q; if (!L.idx(i, q)) return false;
            const int pm = q >> 2, pn = q & 3; const size_t ro = (size_t)pm * 256 * 1024 + pn * 256;
            u.a = A + (size_t)pm * a_tile_bytes; u.b = Bt + (size_t)pn * b_tile_bytes;
            u.p1 = (flags & 1) ? (const float*)((const bf16_t*)base_lat + ro) : (const float*)base_lat + ro;
            u.o = (flags & 2) ? (char*)((bf16_t*)out_lat + ro) : (char*)((float*)out_lat + ro);
            u.p2 = gate + (size_t)(pm >> 3) * 6144 + pn * 256; u.nt = ntk; u.mode = 0; u.half = 0; u.mk = -1; u.mneg = 0; return true; }
        if (!with_ctx) return false;
        g8::ListOrder L{32 * nsp, G, c}; int q; if (!L.idx(i - r0, q)) return false;
        const int un = q / nsp, part = q % nsp, pm = un >> 2, pn = un & 3, k0 = part * ntp; const size_t ro = (size_t)pm * 256 * 1024 + pn * 256;
        u.a = A + (size_t)(64 + pm) * a_tile_bytes + (size_t)k0 * 128; u.b = Bt + (size_t)pn * b_tile_bytes + (size_t)k0 * 128;
        u.p1 = nullptr; u.o = (char*)(ws + OFF_S) + ((size_t)part * 2048 * 1024 + ro) * 2; u.p2 = gate + (size_t)8 * 6144 + pn * 256;
        u.nt = (part == nsp - 1) ? (ntk - k0) : ntp; u.mode = 1; u.half = 0; u.mk = -1; u.mneg = 0; return true;
    }
};
struct SchedFfn1 {
    g8::ListOrderH L; unsigned char* ws; size_t wo;
    __device__ __forceinline__ bool next(int i, Unit& u) const {
        int q, hf; if (!L.idx(i, q, hf)) return false;
        const int gid = q / 176, rem = q % 176, pm = gid * 8 + (rem & 7), pn = rem >> 3;
        u.a = (const char*)(ws + OFF_HY) + (size_t)pm * 256 * 2048; u.b = (const char*)(ws + OFF_W13 + wo) + (size_t)pn * 256 * 2048;
        u.o = (char*)(ws + OFF_U) + ((size_t)pm * 256 * DFF + pn * 128) * 2; u.ldo = DFF; u.cmax = 128; u.p1 = nullptr; u.p2 = nullptr; u.nt = 16; u.mode = 0; u.half = 0; u.mk = -1; u.mneg = 0;
        if (hf) { u.half = 1; if (hf == 2) { u.a += (size_t)128 * 2048; u.o += (size_t)128 * DFF * 2; } }
        return true;
    }
};

__device__ __forceinline__ void phase0(int wv, const Params& p, LAS unsigned char* lds, int cb_first, int cb_stride, int cb_lo, int cb_hi, bool do_rope) {
    const int tid = otid(wv);
    float* mod = (float*)(p.ws + OFF_MOD);
    LAS float* sc = (LAS float*)lds;
    LAS float* part = (LAS float*)(lds + 36864);
    for (int cb = cb_lo + cb_first; cb < cb_hi; cb += cb_stride) {
        __syncthreads();
        for (int e = tid; e < 9216; e += 512) { const int i = e >> 10, k = e & 1023; const float v = (i < 8) ? p.c[i * 1024 + k] : p.c_ctx[k]; sc[e] = v / (1.f + expf(-v)); }
        __syncthreads();
        const int l = cb / 96, nb = cb % 96, nl = tid & 63, ks = tid >> 6;
        const float* w = p.ada_w + ((size_t)l * 1024 + ks * 128) * 6144 + nb * 64 + nl;
        float acc[9];
#pragma unroll
        for (int i = 0; i < 9; ++i) acc[i] = 0.f;
        for (int k0 = 0; k0 < 128; k0 += 16) { float wq[16];
#pragma unroll
            for (int u = 0; u < 16; ++u) wq[u] = w[(size_t)(k0 + u) * 6144];
#pragma unroll
            for (int u = 0; u < 16; ++u)
#pragma unroll
                for (int i = 0; i < 9; ++i) acc[i] += sc[i * 1024 + ks * 128 + k0 + u] * wq[u]; }
#pragma unroll
        for (int i = 0; i < 9; ++i) part[(ks * 9 + i) * 64 + nl] = acc[i];
        __syncthreads();
        for (int e = tid; e < 576; e += 512) { const int i = e >> 6, nn = e & 63; float s = 0.f;
#pragma unroll
            for (int k2 = 0; k2 < 8; ++k2) s += part[(k2 * 9 + i) * 64 + nn];
            mod[((size_t)l * 9 + i) * 6144 + nb * 64 + nn] = s + p.ada_b[l * 6144 + nb * 64 + nn]; }
    }
    const size_t gtid = (size_t)blockIdx.x * 512 + tid;
    if (do_rope && gtid < 768) { const int pos = (int)gtid / 12, i = (int)gtid % 12; float sn, cn; sincosf((float)pos * exp2f(-(float)i * 1.1073093649624542f), &sn, &cn);
        float* rp = (float*)(p.ws + OFF_ROPE) + gtid * 2; rp[0] = cn; rp[1] = sn; }
}

__device__ __forceinline__ void trig_tables(int wv, const Params& p, LAS unsigned char* lds, int first, int nblk) {
    const int tid = otid(wv);
    const size_t gtid = (size_t)first * 512 + tid, gstride = (size_t)nblk * 512;
    __syncthreads();
    LAS float* ct = (LAS float*)lds; LAS float* st = ct + 2048;
    for (int e = tid; e < 2048; e += 512) { const float ang = (float)e * (1.0f / 1024.0f); ct[e] = cospif(ang); st[e] = sinpif(ang); }
    __syncthreads();
    unsigned* TL = (unsigned*)(p.ws + OFF_TL);
    for (size_t e = gtid; e < (size_t)4096 * 1024; e += gstride) {
        const int r = (int)(e >> 10), l0 = (int)(e & 1023) * 2, rr = r & 2047; const LAS float* tb = r < 2048 ? ct : st;
        const float v0 = tb[(rr * l0) & 2047] * 0.022097086912079608f, v1 = tb[(rr * (l0 + 1)) & 2047] * 0.022097086912079608f;
        TL[e] = pk_bf16(v0, v1);
    }
    unsigned* TC = (unsigned*)(p.ws + OFF_TC);
    for (size_t e = gtid; e < (size_t)512 * 128; e += gstride) {
        const int r = (int)(e >> 7), l0 = (int)(e & 127) * 2, rr = r & 255; const LAS float* tb = r < 256 ? ct : st;
        const float v0 = tb[((rr * l0) & 255) * 8] * 0.0625f, v1 = tb[((rr * (l0 + 1)) & 255) * 8] * 0.0625f;
        TC[e] = pk_bf16(v0, v1);
    }
    __syncthreads();
}

__device__ __forceinline__ void phase_norm(int wv, const Params& p, int l, int which, int nrows, int nparts, const float* rgate) {
    const int tid = otid(wv), lane = tid & 63, gw = blockIdx.x * 8 + (tid >> 6), nw = gridDim.x * 8;
    const float* mod = (const float*)(p.ws + OFF_MOD) + (size_t)l * 9 * 6144;
    const float* gain = (which ? p.norm_ffn : p.norm_mix) + l * 1024;
    bf16_t* H = (bf16_t*)(p.ws + OFF_HY);
    const bf16_t* XB = (const bf16_t*)(p.ws + OFF_XB);
    const bool wide = !(l == 0 && which == 0);
    int cq[4];
#pragma unroll
    for (int q = 0; q < 4; ++q) cq[q] = wide ? (q >> 1) * 512 + lane * 8 + (q & 1) * 4 : q * 256 + lane * 4;
    for (int row0 = gw; row0 < nrows; row0 += 3 * nw) {
        f32x4 v[3][4]; float ss[3];
#pragma unroll
        for (int u = 0; u < 3; ++u) { const int row = row0 + u * nw; ss[u] = 0.f;
            if (row < nrows) { const bool lat = row < MLAT;
                if (!wide) { const float* src = lat ? p.x + (size_t)row * 1024 : p.ctx + (size_t)(row - MLAT) * 1024;
#pragma unroll
                    for (int q = 0; q < 4; ++q) v[u][q] = *(const f32x4*)(src + cq[q]); }
                else {
#pragma unroll
                    for (int jj = 0; jj < 2; ++jj) { const u32x4 w = *(const u32x4*)(XB + (size_t)row * 1024 + jj * 512 + lane * 8);
                        v[u][2 * jj] = (f32x4){bflo(w.x), bfhi(w.x), bflo(w.y), bfhi(w.y)}; v[u][2 * jj + 1] = (f32x4){bflo(w.z), bfhi(w.z), bflo(w.w), bfhi(w.w)}; } } }
            else {
#pragma unroll
                for (int q = 0; q < 4; ++q) v[u][q] = (f32x4){0.f, 0.f, 0.f, 0.f}; } }
#pragma unroll
        for (int u = 0; u < 3; ++u) { const int row = row0 + u * nw;
            if (row < nrows) { const bool lat = row < MLAT; const bool cpy = (l == 0 && which == 0 && !lat);
                if (!lat && nparts > 0) {
#pragma unroll
                    for (int jj = 0; jj < 2; ++jj) { f32x4 s0 = (f32x4){0.f, 0.f, 0.f, 0.f}, s1 = s0;
                        for (int pt = 0; pt < nparts; ++pt) { const u32x4 w = *(const u32x4*)((const bf16_t*)(p.ws + OFF_S) + (size_t)pt * 2048 * 1024 + (size_t)(row - MLAT) * 1024 + jj * 512 + lane * 8);
                            s0 += (f32x4){bflo(w.x), bfhi(w.x), bflo(w.y), bfhi(w.y)}; s1 += (f32x4){bflo(w.z), bfhi(w.z), bflo(w.w), bfhi(w.w)}; }
                        v[u][2 * jj] += *(const f32x4*)(rgate + cq[2 * jj]) * s0; v[u][2 * jj + 1] += *(const f32x4*)(rgate + cq[2 * jj + 1]) * s1;
                        u32x4 w; w.x = pk_bf16(v[u][2 * jj][0], v[u][2 * jj][1]); w.y = pk_bf16(v[u][2 * jj][2], v[u][2 * jj][3]); w.z = pk_bf16(v[u][2 * jj + 1][0], v[u][2 * jj + 1][1]); w.w = pk_bf16(v[u][2 * jj + 1][2], v[u][2 * jj + 1][3]);
                        *(u32x4*)((bf16_t*)(p.ws + OFF_XB) + (size_t)row * 1024 + jj * 512 + lane * 8) = w; } }
#pragma unroll
                for (int q = 0; q < 4; ++q) {
                    if (cpy) { u32x2 w; w.x = pk_bf16(v[u][q][0], v[u][q][1]); w.y = pk_bf16(v[u][q][2], v[u][q][3]); *(u32x2*)((bf16_t*)(p.ws + OFF_XB) + (size_t)row * 1024 + cq[q]) = w; }
                    ss[u] += v[u][q][0] * v[u][q][0] + v[u][q][1] * v[u][q][1] + v[u][q][2] * v[u][q][2] + v[u][q][3] * v[u][q][3]; } } }
#pragma unroll
        for (int o = 32; o >= 1; o >>= 1) {
#pragma unroll
            for (int u = 0; u < 3; ++u) ss[u] += shx(ss[u], o, lane); }
#pragma unroll
        for (int u = 0; u < 3; ++u) { const int row = row0 + u * nw;
            if (row < nrows) { const bool lat = row < MLAT; const int bi = lat ? (row >> 11) : 8;
                const float* sh = mod + (size_t)bi * 6144 + (which ? 3072 : 0);
                const float* sl = mod + (size_t)bi * 6144 + (which ? 4096 : 1024);
                const float rs = rsqrtf(ss[u] * (1.0f / 1024.0f) + 1e-6f);
                unsigned pk[4][2];
#pragma unroll
                for (int q = 0; q < 4; ++q) { const f32x4 g = *(const f32x4*)(gain + cq[q]), s1 = *(const f32x4*)(sl + cq[q]), s0 = *(const f32x4*)(sh + cq[q]); float r[4];
#pragma unroll
                    for (int e = 0; e < 4; ++e) r[e] = v[u][q][e] * rs * g[e] * (1.f + s1[e]) + s0[e];
                    pk[q][0] = pk_bf16(r[0], r[1]); pk[q][1] = pk_bf16(r[2], r[3]); }
                if (wide) {
#pragma unroll
                    for (int jj = 0; jj < 2; ++jj) { u32x4 w; w.x = pk[2 * jj][0]; w.y = pk[2 * jj][1]; w.z = pk[2 * jj + 1][0]; w.w = pk[2 * jj + 1][1]; *(u32x4*)(H + (size_t)row * 1024 + jj * 512 + lane * 8) = w; } }
                else {
#pragma unroll
                    for (int q = 0; q < 4; ++q) { u32x2 w; w.x = pk[q][0]; w.y = pk[q][1]; *(u32x2*)(H + (size_t)row * 1024 + cq[q]) = w; } } } }
    }
}

__device__ __forceinline__ void phase_weights(int wv, const Params& p, int l, LAS unsigned char* lds, int first, int stride) {
    const size_t wo = (size_t)0 * WSET;
    asm volatile("" : "+s"(stride));
    const int tid = otid(wv);
    LAS float* tile = (LAS float*)lds;
    LAS float* cs = (LAS float*)(lds + 33792);
    if (tid < 64) { cs[tid] = cospif((float)tid * (1.0f / 32.0f)); cs[64 + tid] = sinpif((float)tid * (1.0f / 32.0f)); }
    const int nl = tid & 63, kq = tid >> 6;
    float rg[16];
    const float* sp = nullptr; int ld = 0, k0 = 0, n0 = 0, K = 0; bf16_t* dst = nullptr;
    int ti = first;
#define WT_DECODE(TI) do { int mat; \
        if ((TI) < 1184) { const int nt = (TI) >> 3; k0 = ((TI) & 7) * 128; K = 1024; \
            if (nt < 16) { mat = 0; n0 = nt * 64; dst = (bf16_t*)(p.ws + OFF_WSW + wo); } \
            else if (nt < 44) { mat = 1; n0 = (nt - 16) * 64; dst = (bf16_t*)(p.ws + OFF_WZ + wo); } \
            else if (nt < 132) { mat = 2; n0 = (nt - 44) * 64; dst = (bf16_t*)(p.ws + OFF_W13 + wo); } \
            else { mat = 3; n0 = (nt - 132) * 64; dst = (bf16_t*)(p.ws + OFF_WOUT + wo); } \
        } else { const int t2 = (TI) - 1184; mat = 4; n0 = (t2 / 22) * 64; k0 = (t2 % 22) * 128; K = 2816; dst = (bf16_t*)(p.ws + OFF_W2 + wo); } \
        const int n = n0 + nl; sp = nullptr; ld = 0; \
        if (mat == 0) { const int col = n < 256 ? n : (n < 640 ? 1024 + (n - 256) : 1792 + (n - 640)); sp = p.w_in + (size_t)l * 1024 * NINW + col; ld = NINW; } \
        else if (mat == 1) { if (n < ZLD) { const int col = n < 768 ? 256 + n : (n < 1152 ? 1408 + (n - 768) : 2176 + (n - 1152)); sp = p.w_in + (size_t)l * 1024 * NINW + col; ld = NINW; } } \
        else if (mat == 2) { const int i2 = n & 15, J = (n >> 8) * 128 + ((n >> 5) & 3) * 32 + (i2 >> 2) * 8 + ((n >> 7) & 1) * 4 + (i2 & 3); sp = ((n & 16) ? p.ffn_w3 : p.ffn_w1) + (size_t)l * 1024 * DFF + J; ld = DFF; } \
        else if (mat == 3) { sp = p.w_out + (size_t)l * 1024 * 1024 + n; ld = 1024; } \
        else { sp = p.ffn_w2 + (size_t)l * DFF * 1024 + n; ld = 1024; } } while (0)
#define WT_LOAD() do { _Pragma("unroll") for (int i = 0; i < 16; ++i) rg[i] = sp ? sp[(size_t)(k0 + kq + i * 8) * ld] : 0.f; } while (0)
    if (ti < 1536) { WT_DECODE(ti); WT_LOAD(); }
    while (ti < 1536) {
        bf16_t* cdst = dst + (size_t)n0 * K + k0; const int cK = K;
        __syncthreads();
#pragma unroll
        for (int i = 0; i < 16; ++i) tile[(kq + i * 8) * 65 + nl] = rg[i];
        ti += stride;
        if (ti < 1536) { WT_DECODE(ti); WT_LOAD(); }
        __syncthreads();
        { const int nn = tid >> 3, ks = tid & 7; float v[16];
#pragma unroll
            for (int j = 0; j < 16; ++j) v[j] = tile[(ks * 16 + j) * 65 + nn];
            u32x4 w0, w1; w0.x = pk_bf16(v[0], v[1]); w0.y = pk_bf16(v[2], v[3]); w0.z = pk_bf16(v[4], v[5]); w0.w = pk_bf16(v[6], v[7]);
            w1.x = pk_bf16(v[8], v[9]); w1.y = pk_bf16(v[10], v[11]); w1.z = pk_bf16(v[12], v[13]); w1.w = pk_bf16(v[14], v[15]);
            bf16_t* o = cdst + (size_t)nn * cK + ks * 16; *(u32x4*)o = w0; *(u32x4*)(o + 8) = w1; }
    }
#undef WT_DECODE
#undef WT_LOAD
    __syncthreads();
    bf16_t* WF = (bf16_t*)(p.ws + OFF_WF + wo);
    const float* fw = p.fnet_w + (size_t)l * 65536;
    for (int idx = first * 512 + tid; idx < 131072; idx += stride * 512) {
        const int n = idx & 255, k = idx >> 8, part = k >> 8, g = (k & 255) >> 6, j = k & 63; float s = 0.f;
        for (int m = 0; m < 64; ++m) s += cs[part * 64 + ((m * j) & 63)] * fw[(size_t)(g * 64 + m) * 256 + n];
        WF[(size_t)n * 512 + k] = f2bf(part ? -0.125f * s : 0.125f * s);
    }
}

constexpr int NA_KLOC = 0, NA_VLOC = 36864, NA_KCTX = 70656, NA_VCTX = 89088, NA_RPB = 106496;
__device__ __forceinline__ u32x4 norm_krow(u32x4 w, int lane) {
    float v[8]; v[0] = bflo(w.x); v[1] = bfhi(w.x); v[2] = bflo(w.y); v[3] = bfhi(w.y); v[4] = bflo(w.z); v[5] = bfhi(w.z); v[6] = bflo(w.w); v[7] = bfhi(w.w);
    float ss = 0.f;
#pragma unroll
    for (int e = 0; e < 8; ++e) ss += v[e] * v[e];
    ss += shx(ss, 1, lane); ss += shx(ss, 2, lane); ss += shx(ss, 4, lane);
    const float rk = rsqrtf(ss * (1.0f / 64.0f) + 1e-6f);
    u32x4 o; o.x = pk_bf16(v[0] * rk, v[1] * rk); o.y = pk_bf16(v[2] * rk, v[3] * rk); o.z = pk_bf16(v[4] * rk, v[5] * rk); o.w = pk_bf16(v[6] * rk, v[7] * rk); return o;
}
constexpr int NB_KLOC = 0, NB_VLOC = 46080, NB_KCTX = 88064, NB_VCTX = 106496, NB_RPB = 123904;
template <int ND>
__device__ __forceinline__ void na_step(LAS unsigned char* lds, int kbase, int vbase, int vstr, const int (&key0)[ND], bool loc, const int (&dr)[ND], const LAS float* rpb,
                                        const bf16x8 (&qf)[2], int fr, int fq, int lane, int cst, int cq, int c0w, float& m_run, float& l_run, f32x4 (&O)[4]) {
    f32x4 sc[2 * ND];
#pragma unroll
    for (int u = 0; u < 2 * ND; ++u) sc[u] = (f32x4){0.f, 0.f, 0.f, 0.f};
    __builtin_amdgcn_s_setprio(1);
#pragma unroll
    for (int kk = 0; kk < 2; ++kk)
#pragma unroll
        for (int u = 0; u < 2 * ND; ++u) {
            const bf16x8 kf = *(const LAS bf16x8*)(lds + kbase + (key0[u >> 1] + (u & 1) * 16 + fr) * 144 + kk * 64 + fq * 16);
            sc[u] = mfma16(kf, qf[kk], sc[u]); }
    __builtin_amdgcn_s_setprio(0);
    if (loc) {
#pragma unroll
        for (int g = 0; g < ND; ++g)
#pragma unroll
            for (int i = 0; i < 4; ++i) {
                const int ck0 = cst + fq * 4 + i, ck1 = ck0 + 16;
                const int rel0 = min(max(ck0 - cq + 15, 0), 30), rel1 = min(max(ck1 - cq + 15, 0), 30);
                const bool v0 = (ck0 >= c0w) && (ck0 < c0w + 16), v1 = (ck1 >= c0w) && (ck1 < c0w + 16);
                sc[2 * g][i] = v0 ? sc[2 * g][i] + rpb[dr[g] * 31 + rel0] : -INFINITY;
                sc[2 * g + 1][i] = v1 ? sc[2 * g + 1][i] + rpb[dr[g] * 31 + rel1] : -INFINITY; }
    }
    float mx = -INFINITY;
#pragma unroll
    for (int u = 0; u < 2 * ND; ++u) mx = fmaxf(mx, fmaxf(fmaxf(sc[u][0], sc[u][1]), fmaxf(sc[u][2], sc[u][3])));
    mx = xmax16(mx); mx = xmax32(mx);
    const float m_new = fmaxf(m_run, mx);
    const float m_use = (m_new == -INFINITY) ? 0.f : m_new;
    const float alpha = __builtin_amdgcn_exp2f(m_run - m_use);
    float ps_sum = 0.f; bf16x8 pf[ND];
#pragma unroll
    for (int g = 0; g < ND; ++g) { float pv[8];
#pragma unroll
        for (int i = 0; i < 4; ++i) { pv[i] = __builtin_amdgcn_exp2f(sc[2 * g][i] - m_use); pv[4 + i] = __builtin_amdgcn_exp2f(sc[2 * g + 1][i] - m_use); ps_sum += pv[i] + pv[4 + i]; }
        u32x4 pw; pw.x = pk_bf16(pv[0], pv[1]); pw.y = pk_bf16(pv[2], pv[3]); pw.z = pk_bf16(pv[4], pv[5]); pw.w = pk_bf16(pv[6], pv[7]);
        pf[g] = as_bf8(pw); }
    l_run = l_run * alpha + ps_sum; m_run = m_new;
    __builtin_amdgcn_s_setprio(1);
#pragma unroll
    for (int d = 0; d < 4; ++d) { O[d] = O[d] * alpha;
#pragma unroll
        for (int g = 0; g < ND; ++g) {
            const u32x2 va = *(const LAS u32x2*)(lds + vbase + (d * 16 + fr) * vstr + (key0[g] + fq * 4) * 2);
            const u32x2 vb = *(const LAS u32x2*)(lds + vbase + (d * 16 + fr) * vstr + (key0[g] + 16 + fq * 4) * 2);
            u32x4 vw; vw.x = va.x; vw.y = va.y; vw.z = vb.x; vw.w = vb.y;
            O[d] = mfma16(as_bf8(vw), pf[g], O[d]); } }
    __builtin_amdgcn_s_setprio(0);
}
__device__ __forceinline__ void na_item(int wv, const Params& p, int l, int it, LAS unsigned char* lds) {
    const int tid = otid(wv), lane = tid & 63, wave = __builtin_amdgcn_readfirstlane(tid >> 6), fr = lane & 15, fq = lane >> 4;
    const bf16_t* Z = (const bf16_t*)(p.ws + OFF_Z); const bf16_t* TLAT = (const bf16_t*)(p.ws + OFF_TLAT); const bf16_t* TCTX = (const bf16_t*)(p.ws + OFF_TCTX);
    bf16_t* Y = (bf16_t*)(p.ws + OFF_HY);
    const bool lat = it < 768; int b, h, rho = 0, g2 = 0;
    if (lat) { b = it / 96; const int rem = it % 96; h = rem >> 4; rho = rem & 15; } else { const int ci = it - 768; b = ci / 12; h = (ci % 12) >> 1; g2 = ci & 1; }
    const int r0a = min(max(2 * rho - 4, 0), 24), r0b = min(max(2 * rho - 3, 0), 24), dd = r0b - r0a;
    const int rsel = wave >> 2, j = wave & 3;
    const int r = 2 * rho + rsel, r0 = rsel ? r0b : r0a, off = rsel ? dd : 0;
    const int cst = (j == 0) ? 0 : (j == 1 ? 8 : (j == 2 ? 24 : 32));
    const int qrow = lat ? (b * 2048 + r * 64 + 16 * j + fr) : (MLAT + b * 256 + g2 * 128 + wave * 16 + fr);
    LAS float* rpb = (LAS float*)(lds + NB_RPB);
    bf16x8 qf[2];
    { const bf16_t* qp = Z + (size_t)qrow * ZLD + h * 64 + fq * 8;
      const u32x4 w0 = *(const u32x4*)qp, w1 = *(const u32x4*)(qp + 32);
      float v[16]; v[0] = bflo(w0.x); v[1] = bfhi(w0.x); v[2] = bflo(w0.y); v[3] = bfhi(w0.y); v[4] = bflo(w0.z); v[5] = bfhi(w0.z); v[6] = bflo(w0.w); v[7] = bfhi(w0.w);
      v[8] = bflo(w1.x); v[9] = bfhi(w1.x); v[10] = bflo(w1.y); v[11] = bfhi(w1.y); v[12] = bflo(w1.z); v[13] = bfhi(w1.z); v[14] = bflo(w1.w); v[15] = bfhi(w1.w);
      float ss = 0.f;
#pragma unroll
      for (int e = 0; e < 16; ++e) ss += v[e] * v[e];
      ss = xsum16(ss); ss = xsum32(ss);
      const float rq = rsqrtf(ss * (1.0f / 64.0f) + 1e-6f) * 0.125f * LOG2E;
      const float* gq = p.na_q_norm + l * 64; const float* gk = p.na_k_norm + l * 64;
#pragma unroll
      for (int e = 0; e < 8; ++e) { v[e] *= rq * gq[fq * 8 + e] * gk[fq * 8 + e]; v[8 + e] *= rq * gq[32 + fq * 8 + e] * gk[32 + fq * 8 + e]; }
      u32x4 a, c; a.x = pk_bf16(v[0], v[1]); a.y = pk_bf16(v[2], v[3]); a.z = pk_bf16(v[4], v[5]); a.w = pk_bf16(v[6], v[7]);
      c.x = pk_bf16(v[8], v[9]); c.y = pk_bf16(v[10], v[11]); c.z = pk_bf16(v[12], v[13]); c.w = pk_bf16(v[14], v[15]);
      qf[0] = as_bf8(a); qf[1] = as_bf8(c); }
    float m_run = -INFINITY, l_run = 0.f;
    f32x4 O[4];
#pragma unroll
    for (int d = 0; d < 4; ++d) O[d] = (f32x4){0.f, 0.f, 0.f, 0.f};
    const int cq = 16 * j + fr, c0w = min(max(cq - 8, 0), 48);
    u32x4 kl[5], vl[5], kc[2], vc[2];
#define NA_LOAD(PS) do { \
        if (lat) { const int nk = ((PS) ? 3 + dd : 5) * 64; const int tk0 = b * 2048 + (r0a + 5 * (PS)) * 64; \
            _Pragma("unroll") for (int i = 0; i < 5; ++i) { const int e = tid + i * 512, key = e >> 3, seg = e & 7; \
                kl[i] = (key < nk) ? *(const u32x4*)(Z + (size_t)(tk0 + key) * ZLD + ZC_NK + h * 64 + seg * 8) : (u32x4){0u, 0u, 0u, 0u}; } \
            _Pragma("unroll") for (int i = 0; i < 5; ++i) { const int e = tid + i * 512, d = e / 40, seg = e % 40; \
                vl[i] = (seg * 8 < nk) ? *(const u32x4*)(TLAT + ((size_t)(b * 1024 + TC_NV + h * 64 + d)) * 2048 + (r0a + 5 * (PS)) * 64 + seg * 8) : (u32x4){0u, 0u, 0u, 0u}; } } \
        _Pragma("unroll") for (int i = 0; i < 2; ++i) { const int e = tid + i * 512, key = e >> 3, seg = e & 7; \
            kc[i] = *(const u32x4*)(Z + (size_t)(MLAT + b * 256 + 128 * (PS) + key) * ZLD + ZC_NK + h * 64 + seg * 8); } \
        _Pragma("unroll") for (int i = 0; i < 2; ++i) { const int e = tid + i * 512, d = e >> 4, seg = e & 15; \
            vc[i] = *(const u32x4*)(TCTX + ((size_t)(b * 1024 + TC_NV + h * 64 + d)) * 256 + 128 * (PS) + seg * 8); } } while (0)
    NA_LOAD(0);
    for (int ps = 0; ps < 2; ++ps) {
        __syncthreads();
        if (ps == 0 && lat) for (int e = tid; e < 465; e += 512) rpb[e] = p.na_rpb[(size_t)(l * 6 + h) * 465 + e] * LOG2E;
        if (lat) {
#pragma unroll
            for (int i = 0; i < 5; ++i) { const int e = tid + i * 512, key = e >> 3, seg = e & 7; *(LAS u32x4*)(lds + NB_KLOC + key * 144 + seg * 16) = norm_krow(kl[i], lane); }
#pragma unroll
            for (int i = 0; i < 5; ++i) { const int e = tid + i * 512, d = e / 40, seg = e % 40; *(LAS u32x4*)(lds + NB_VLOC + d * 656 + seg * 16) = vl[i]; }
        }
#pragma unroll
        for (int i = 0; i < 2; ++i) { const int e = tid + i * 512, key = e >> 3, seg = e & 7; *(LAS u32x4*)(lds + NB_KCTX + key * 144 + seg * 16) = norm_krow(kc[i], lane); }
#pragma unroll
        for (int i = 0; i < 2; ++i) { const int e = tid + i * 512, d = e >> 4, seg = e & 15; *(LAS u32x4*)(lds + NB_VCTX + d * 272 + seg * 16) = vc[i]; }
        __syncthreads();
        if (ps == 0) NA_LOAD(1);
        if (lat) {
            const int p0 = 5 * ps, lo = max(off, p0), hi = min(off + 8, ps ? 9 : 5);
            int rel = lo;
            for (; rel + 1 < hi; rel += 2) { const int key0[2] = {(rel - p0) * 64 + cst, (rel + 1 - p0) * 64 + cst}; const int dr[2] = {(r0 + rel - off) - r + 7, (r0 + rel + 1 - off) - r + 7};
                na_step<2>(lds, NB_KLOC, NB_VLOC, 656, key0, true, dr, rpb, qf, fr, fq, lane, cst, cq, c0w, m_run, l_run, O); }
            if (rel < hi) { const int key0[1] = {(rel - p0) * 64 + cst}; const int dr[1] = {(r0 + rel - off) - r + 7};
                na_step<1>(lds, NB_KLOC, NB_VLOC, 656, key0, true, dr, rpb, qf, fr, fq, lane, cst, cq, c0w, m_run, l_run, O); }
        }
        { const int dr[4] = {0, 0, 0, 0}; const int key0[4] = {0, 32, 64, 96};
          na_step<4>(lds, NB_KCTX, NB_VCTX, 272, key0, false, dr, rpb, qf, fr, fq, lane, cst, cq, c0w, m_run, l_run, O); }
    }
#undef NA_LOAD
    l_run = xsum16(l_run); l_run = xsum32(l_run);
    const float inv = 1.0f / l_run;
#pragma unroll
    for (int d = 0; d < 4; ++d) { u32x2 w; w.x = pk_bf16(O[d][0] * inv, O[d][1] * inv); w.y = pk_bf16(O[d][2] * inv, O[d][3] * inv);
        *(u32x2*)(Y + (size_t)qrow * 1024 + 256 + h * 64 + d * 16 + fq * 4) = w; }
}

constexpr int GL_GT = 0, GL_G = 13824, GL_Q = 39424, GL_K = 57856, GL_VT = 76288, GL_X = 90112, GL_ST = 108544;
__device__ __forceinline__ int gla_row0(int b, int n) { return n < 32 ? b * 2048 + n * 64 : MLAT + b * 256 + (n - 32) * 64; }
struct PrepRegs { u32x4 ga[3]; u32x4 bw[3]; float bias[3]; };
__device__ __forceinline__ void gla_prep_load(PrepRegs& R, const Params& p, int l, int h, int row0, int wave, int fr, int fq) {
    const bf16_t* Z = (const bf16_t*)(p.ws + OFF_Z);
#pragma unroll
    for (int q = 0; q < 3; ++q) { const int tile = wave * 3 + q, mi = tile / 6, ni = tile % 6, dir = ni / 3, c = (ni % 3) * 16 + fr;
        R.ga[q] = *(const u32x4*)(Z + (size_t)(row0 + mi * 16 + fr) * ZLD + ZC_GA + fq * 8);
        R.bw[q] = (u32x4){0u, 0u, 0u, 0u};
        if ((fq >> 1) == dir) { const float* aw = p.gla_alpha_w + ((size_t)(l * 2 + dir) * 16 + (fq & 1) * 8) * 192 + h * 48 + c; float w[8];
#pragma unroll
            for (int e = 0; e < 8; ++e) w[e] = aw[e * 192];
            R.bw[q].x = pk_bf16(w[0], w[1]); R.bw[q].y = pk_bf16(w[2], w[3]); R.bw[q].z = pk_bf16(w[4], w[5]); R.bw[q].w = pk_bf16(w[6], w[7]); }
        R.bias[q] = p.gla_alpha_b[(size_t)(l * 2 + dir) * 192 + h * 48 + c]; }
}
__device__ __forceinline__ void gla_prep(const PrepRegs& R, LAS unsigned char* lds, int wave, int fr, int fq) {
    LAS float* G = (LAS float*)(lds + GL_G);
    __syncthreads();
#pragma unroll
    for (int q = 0; q < 3; ++q) { const int tile = wave * 3 + q, mi = tile / 6, ni = tile % 6, dir = ni / 3, c = (ni % 3) * 16 + fr;
        const f32x4 acc = mfma16(as_bf8(R.ga[q]), as_bf8(R.bw[q]), (f32x4){0.f, 0.f, 0.f, 0.f});
        float g[4];
#pragma unroll
        for (int i = 0; i < 4; ++i) { const float sv = acc[i] + R.bias[q]; g[i] = (fminf(sv, 0.f) - __logf(1.f + __expf(-fabsf(sv)))) * (1.0f / 16.0f); }
        u32x2 w2; w2.x = pk_bf16(g[0], g[1]); w2.y = pk_bf16(g[2], g[3]);
        *(LAS u32x2*)(lds + GL_GT + (dir * 48 + c) * 144 + (mi * 16 + fq * 4) * 2) = w2; }
    __syncthreads();
#pragma unroll
    for (int q = 0; q < 3; ++q) { const int tile = wave * 3 + q, mi = tile / 6, ni = tile % 6, dir = ni / 3;
        f32x4 acc = (f32x4){0.f, 0.f, 0.f, 0.f};
#pragma unroll
        for (int kk = 0; kk < 2; ++kk) { const int t = mi * 16 + fr; bf16x8 tri;
#pragma unroll
            for (int e = 0; e < 8; ++e) { const int sidx = kk * 32 + fq * 8 + e; tri[e] = (dir ? (sidx >= t) : (sidx <= t)) ? (short)0x3F80 : (short)0; }
            const bf16x8 bb = *(const LAS bf16x8*)(lds + GL_GT + (ni * 16 + fr) * 144 + kk * 64 + fq * 16);
            acc = mfma16(tri, bb, acc); }
#pragma unroll
        for (int i = 0; i < 4; ++i) G[(dir * 64 + mi * 16 + fq * 4 + i) * 48 + (ni % 3) * 16 + fr] = acc[i]; }
    __syncthreads();
}
__device__ __forceinline__ void gla_g1_item(int wv, const Params& p, int l, int it, LAS unsigned char* lds) {
    const int tid = otid(wv), lane = tid & 63, wave = tid >> 6, fr = lane & 15, fq = lane >> 4;
    const int b = it / 144, rem = it % 144, n = rem >> 2, h = rem & 3;
    const int row0 = gla_row0(b, n); const bool latent = n < 32;
    const bf16_t* Z = (const bf16_t*)(p.ws + OFF_Z);
    PrepRegs R; gla_prep_load(R, p, l, h, row0, wave, fr, fq);
    const int t3 = tid / 6, r6 = tid % 6, half = r6 / 3, j4 = (r6 % 3) * 4, c1 = half * 24 + j4;
    u32x2 w1 = (u32x2){0u, 0u}, w2 = (u32x2){0u, 0u}; f32x4 ra = (f32x4){1.f, 0.f, 1.f, 0.f}, rb = ra;
    if (tid < 384) { const bf16_t* zr = Z + (size_t)(row0 + t3) * ZLD + ZC_GK + h * 48 + c1; w1 = *(const u32x2*)zr; w2 = *(const u32x2*)(zr + 12);
        if (latent) { const float* rp = (const float*)(p.ws + OFF_ROPE) + ((half ? t3 : n) * 12 + j4) * 2; ra = *(const f32x4*)rp; rb = *(const f32x4*)(rp + 4); } }
    const bf16_t* vsrc = latent ? (const bf16_t*)(p.ws + OFF_TLAT) + ((size_t)(b * 1024 + TC_GV + h * 96)) * 2048 + n * 64
                                : (const bf16_t*)(p.ws + OFF_TCTX) + ((size_t)(b * 1024 + TC_GV + h * 96)) * 256 + (n - 32) * 64;
    const int vld = latent ? 2048 : 256;
    u32x4 vw[2];
#pragma unroll
    for (int i = 0; i < 2; ++i) { const int e = tid + i * 512; vw[i] = (e < 768) ? *(const u32x4*)(vsrc + (size_t)(e >> 3) * vld + (e & 7) * 8) : (u32x4){0u, 0u, 0u, 0u}; }
    gla_prep(R, lds, wave, fr, fq);
    LAS float* G = (LAS float*)(lds + GL_G);
    if (tid < 384) { const int t = t3;
        float x1[4] = {bflo(w1.x), bfhi(w1.x), bflo(w1.y), bfhi(w1.y)}, x2[4] = {bflo(w2.x), bfhi(w2.x), bflo(w2.y), bfhi(w2.y)};
        { const float cn[4] = {ra[0], ra[2], rb[0], rb[2]}, sn[4] = {ra[1], ra[3], rb[1], rb[3]};
#pragma unroll
            for (int e = 0; e < 4; ++e) { const float a1 = x1[e], a2 = x2[e]; x1[e] = a1 * cn[e] - a2 * sn[e]; x2[e] = a2 * cn[e] + a1 * sn[e]; } }
#pragma unroll
        for (int dir = 0; dir < 2; ++dir) { const int tl = dir ? 0 : 63;
            const f32x4 b1 = *(const LAS f32x4*)(G + (dir * 64 + t) * 48 + c1), b2 = *(const LAS f32x4*)(G + (dir * 64 + t) * 48 + c1 + 12);
            const f32x4 l1 = *(const LAS f32x4*)(G + (dir * 64 + tl) * 48 + c1), l2 = *(const LAS f32x4*)(G + (dir * 64 + tl) * 48 + c1 + 12);
#pragma unroll
            for (int e = 0; e < 4; ++e) {
                *(LAS bf16_t*)(lds + GL_X + (dir * 48 + c1 + e) * 144 + t * 2) = f2bf(x1[e] * __expf(l1[e] - b1[e]));
                *(LAS bf16_t*)(lds + GL_X + (dir * 48 + c1 + 12 + e) * 144 + t * 2) = f2bf(x2[e] * __expf(l2[e] - b2[e])); } } }
#pragma unroll
    for (int i = 0; i < 2; ++i) { const int e = tid + i * 512; if (e < 768) *(LAS u32x4*)(lds + GL_VT + (e >> 3) * 144 + (e & 7) * 16) = vw[i]; }
    bf16_t* Sb = (bf16_t*)(p.ws + OFF_S); float* DEC = (float*)(p.ws + OFF_DEC);
    if (tid < 96) { const int dir = tid / 48, c = tid % 48; const size_t slot = (size_t)((b * 4 + h) * 2 + dir) * 36 + n;
        DEC[slot * 48 + c] = __expf(dir ? G[64 * 48 + c] : G[63 * 48 + c]); }
    __syncthreads();
    for (int tl = wave; tl < 36; tl += 8) { const int dir = tl / 18, r2 = tl % 18, mi = r2 / 3, ni = r2 % 3;
        f32x4 acc = (f32x4){0.f, 0.f, 0.f, 0.f};
#pragma unroll
        for (int kk = 0; kk < 2; ++kk) {
            const bf16x8 a = *(const LAS bf16x8*)(lds + GL_VT + (mi * 16 + fr) * 144 + kk * 64 + fq * 16);
            const bf16x8 bb = *(const LAS bf16x8*)(lds + GL_X + (dir * 48 + ni * 16 + fr) * 144 + kk * 64 + fq * 16);
            acc = mfma16(a, bb, acc); }
        bf16_t* dst = Sb + ((size_t)((b * 4 + h) * 2 + dir) * 36 + n) * 4608;
#pragma unroll
        for (int i = 0; i < 4; ++i) dst[(mi * 16 + fq * 4 + i) * 48 + ni * 16 + fr] = f2bf(acc[i]); }
}
__device__ __forceinline__ void gla_g3_item(int wv, const Params& p, int l, int b, int n, int h, LAS unsigned char* lds) {
    const int tid = otid(wv), lane = tid & 63, wave = tid >> 6, fr = lane & 15, fq = lane >> 4;
    const int row0 = gla_row0(b, n); const bool latent = n < 32;
    const bf16_t* Z = (const bf16_t*)(p.ws + OFF_Z);
    PrepRegs R; gla_prep_load(R, p, l, h, row0, wave, fr, fq);
    const int t3 = tid / 6, r6 = tid % 6, half = r6 / 3, j4 = (r6 % 3) * 4, c1 = half * 24 + j4;
    u32x2 q1w = (u32x2){0u, 0u}, q2w = q1w, k1w = q1w, k2w = q1w; f32x4 ra = (f32x4){1.f, 0.f, 1.f, 0.f}, rb = ra;
    if (tid < 384) { const bf16_t* zq = Z + (size_t)(row0 + t3) * ZLD + ZC_GQ + h * 48 + c1; const bf16_t* zk = Z + (size_t)(row0 + t3) * ZLD + ZC_GK + h * 48 + c1;
        q1w = *(const u32x2*)zq; q2w = *(const u32x2*)(zq + 12); k1w = *(const u32x2*)zk; k2w = *(const u32x2*)(zk + 12);
        if (latent) { const float* rp = (const float*)(p.ws + OFF_ROPE) + ((half ? t3 : n) * 12 + j4) * 2; ra = *(const f32x4*)rp; rb = *(const f32x4*)(rp + 4); } }
    const bf16_t* Sb = (const bf16_t*)(p.ws + OFF_S);
    u32x2 sw[5];
#pragma unroll
    for (int i = 0; i < 5; ++i) { const int e = tid + i * 512; if (e < 2304) { const int dir = e / 1152, idx = e % 1152, dv = idx / 12, dk = (idx % 12) * 4;
            sw[i] = *(const u32x2*)(Sb + ((size_t)((b * 4 + h) * 2 + dir) * 36 + n) * 4608 + dv * 48 + dk); } else sw[i] = (u32x2){0u, 0u}; }
    const bf16_t* vsrc = latent ? (const bf16_t*)(p.ws + OFF_TLAT) + ((size_t)(b * 1024 + TC_GV + h * 96)) * 2048 + n * 64
                                : (const bf16_t*)(p.ws + OFF_TCTX) + ((size_t)(b * 1024 + TC_GV + h * 96)) * 256 + (n - 32) * 64;
    const int vld = latent ? 2048 : 256;
    u32x4 vw[2];
#pragma unroll
    for (int i = 0; i < 2; ++i) { const int e = tid + i * 512; vw[i] = (e < 768) ? *(const u32x4*)(vsrc + (size_t)(e >> 3) * vld + (e & 7) * 8) : (u32x4){0u, 0u, 0u, 0u}; }
    const int tf = tid >> 3, part = tid & 7;
    u32x2 ggw[3];
    { const bf16_t* gp = Z + (size_t)(row0 + tf) * ZLD + ZC_GG + h * 96 + part * 12;
#pragma unroll
      for (int q4 = 0; q4 < 3; ++q4) ggw[q4] = *(const u32x2*)(gp + q4 * 4); }
    gla_prep(R, lds, wave, fr, fq);
    LAS float* G = (LAS float*)(lds + GL_G);
    if (tid < 384) { const int t = t3;
        float q1[4] = {bflo(q1w.x), bfhi(q1w.x), bflo(q1w.y), bfhi(q1w.y)}, q2[4] = {bflo(q2w.x), bfhi(q2w.x), bflo(q2w.y), bfhi(q2w.y)};
        float k1[4] = {bflo(k1w.x), bfhi(k1w.x), bflo(k1w.y), bfhi(k1w.y)}, k2[4] = {bflo(k2w.x), bfhi(k2w.x), bflo(k2w.y), bfhi(k2w.y)};
        { const float cn[4] = {ra[0], ra[2], rb[0], rb[2]}, sn[4] = {ra[1], ra[3], rb[1], rb[3]};
#pragma unroll
            for (int e = 0; e < 4; ++e) { float a1 = q1[e], a2 = q2[e]; q1[e] = a1 * cn[e] - a2 * sn[e]; q2[e] = a2 * cn[e] + a1 * sn[e];
                a1 = k1[e]; a2 = k2[e]; k1[e] = a1 * cn[e] - a2 * sn[e]; k2[e] = a2 * cn[e] + a1 * sn[e]; } }
#pragma unroll
        for (int dir = 0; dir < 2; ++dir) {
            const f32x4 b1 = *(const LAS f32x4*)(G + (dir * 64 + t) * 48 + c1), b2 = *(const LAS f32x4*)(G + (dir * 64 + t) * 48 + c1 + 12);
            float e1[4], e2[4], i1[4], i2[4];
#pragma unroll
            for (int e = 0; e < 4; ++e) { e1[e] = __expf(b1[e]); e2[e] = __expf(b2[e]); i1[e] = __expf(-b1[e]); i2[e] = __expf(-b2[e]); }
            const float qs = 0.14433756729740643f;
            u32x2 w;
            w.x = pk_bf16(q1[0] * qs * e1[0], q1[1] * qs * e1[1]); w.y = pk_bf16(q1[2] * qs * e1[2], q1[3] * qs * e1[3]); *(LAS u32x2*)(lds + GL_Q + (dir * 64 + t) * 144 + c1 * 2) = w;
            w.x = pk_bf16(q2[0] * qs * e2[0], q2[1] * qs * e2[1]); w.y = pk_bf16(q2[2] * qs * e2[2], q2[3] * qs * e2[3]); *(LAS u32x2*)(lds + GL_Q + (dir * 64 + t) * 144 + (c1 + 12) * 2) = w;
            w.x = pk_bf16(k1[0] * i1[0], k1[1] * i1[1]); w.y = pk_bf16(k1[2] * i1[2], k1[3] * i1[3]); *(LAS u32x2*)(lds + GL_K + (dir * 64 + t) * 144 + c1 * 2) = w;
            w.x = pk_bf16(k2[0] * i2[0], k2[1] * i2[1]); w.y = pk_bf16(k2[2] * i2[2], k2[3] * i2[3]); *(LAS u32x2*)(lds + GL_K + (dir * 64 + t) * 144 + (c1 + 12) * 2) = w; } }
    for (int e = tid; e < 2048; e += 512) { const int rw = e >> 4, c = 48 + (e & 15);
        *(LAS bf16_t*)(lds + GL_Q + rw * 144 + c * 2) = 0; *(LAS bf16_t*)(lds + GL_K + rw * 144 + c * 2) = 0; }
#pragma unroll
    for (int i = 0; i < 5; ++i) { const int e = tid + i * 512; if (e < 2304) { const int dir = e / 1152, idx = e % 1152, dv = idx / 12, dk = (idx % 12) * 4;
            *(LAS u32x2*)(lds + GL_ST + (dir * 96 + dv) * 144 + dk * 2) = sw[i]; } }
    for (int e = tid; e < 3072; e += 512) { const int rw = e >> 4, c = 48 + (e & 15); *(LAS bf16_t*)(lds + GL_ST + rw * 144 + c * 2) = 0; }
#pragma unroll
    for (int i = 0; i < 2; ++i) { const int e = tid + i * 512; if (e < 768) *(LAS u32x4*)(lds + GL_VT + (e >> 3) * 144 + (e & 7) * 16) = vw[i]; }
    __syncthreads();
    { const int dir = wave >> 2, mi = wave & 3;
      bf16x8 a[2];
#pragma unroll
      for (int kk = 0; kk < 2; ++kk) a[kk] = *(const LAS bf16x8*)(lds + GL_Q + (dir * 64 + mi * 16 + fr) * 144 + kk * 64 + fq * 16);
#pragma unroll
      for (int ni = 0; ni < 4; ++ni) { f32x4 acc = (f32x4){0.f, 0.f, 0.f, 0.f};
#pragma unroll
          for (int kk = 0; kk < 2; ++kk) { const bf16x8 bb = *(const LAS bf16x8*)(lds + GL_K + (dir * 64 + ni * 16 + fr) * 144 + kk * 64 + fq * 16); acc = mfma16(a[kk], bb, acc); }
#pragma unroll
          for (int i = 0; i < 4; ++i) { const int t = mi * 16 + fq * 4 + i, sidx = ni * 16 + fr; const bool keep = dir ? (sidx >= t) : (sidx <= t);
              *(LAS bf16_t*)(lds + GL_X + (dir * 64 + t) * 144 + sidx * 2) = f2bf(keep ? acc[i] : 0.f); } } }
    __syncthreads();
    LAS float* Ob = (LAS float*)lds;
    { const int mi = wave >> 1, nb = (wave & 1) * 3;
#pragma unroll
      for (int nn = 0; nn < 3; ++nn) { const int ni = nb + nn; f32x4 acc = (f32x4){0.f, 0.f, 0.f, 0.f};
#pragma unroll
          for (int dir = 0; dir < 2; ++dir)
#pragma unroll
              for (int kk = 0; kk < 2; ++kk) {
                  const bf16x8 a1 = *(const LAS bf16x8*)(lds + GL_X + (dir * 64 + mi * 16 + fr) * 144 + kk * 64 + fq * 16);
                  const bf16x8 b1 = *(const LAS bf16x8*)(lds + GL_VT + (ni * 16 + fr) * 144 + kk * 64 + fq * 16);
                  acc = mfma16(a1, b1, acc);
                  const bf16x8 a2 = *(const LAS bf16x8*)(lds + GL_Q + (dir * 64 + mi * 16 + fr) * 144 + kk * 64 + fq * 16);
                  const bf16x8 b2 = *(const LAS bf16x8*)(lds + GL_ST + (dir * 96 + ni * 16 + fr) * 144 + kk * 64 + fq * 16);
                  acc = mfma16(a2, b2, acc); }
#pragma unroll
          for (int i = 0; i < 4; ++i) Ob[(mi * 16 + fq * 4 + i) * 97 + ni * 16 + fr] = acc[i]; } }
    __syncthreads();
    { const int t = tf; float o[12]; float ss = 0.f;
#pragma unroll
      for (int e = 0; e < 12; ++e) { o[e] = Ob[t * 97 + part * 12 + e]; ss += o[e] * o[e]; }
      ss += shx(ss, 1, lane); ss += shx(ss, 2, lane); ss += shx(ss, 4, lane);
      const float rs = rsqrtf(ss * (1.0f / 96.0f) + 1e-6f);
      const float* gn = p.gla_o_norm + l * 96 + part * 12;
      bf16_t* yp = (bf16_t*)(p.ws + OFF_HY) + (size_t)(row0 + t) * 1024 + 640 + h * 96 + part * 12;
#pragma unroll
      for (int q4 = 0; q4 < 3; ++q4) { const u32x2 gw = ggw[q4]; float g[4] = {bflo(gw.x), bfhi(gw.x), bflo(gw.y), bfhi(gw.y)}; float r[4];
#pragma unroll
          for (int e = 0; e < 4; ++e) r[e] = o[q4 * 4 + e] * rs * gn[q4 * 4 + e] * (g[e] * __builtin_amdgcn_rcpf(1.f + __expf(-g[e])));
          u32x2 w; w.x = pk_bf16(r[0], r[1]); w.y = pk_bf16(r[2], r[3]); *(u32x2*)(yp + q4 * 4) = w; } }
}
__device__ __forceinline__ void gla_scan(int wv, const Params& p) {
    bf16_t* S = (bf16_t*)(p.ws + OFF_S); const float* DEC = (const float*)(p.ws + OFF_DEC);
    for (int e = blockIdx.x * 512 + otid(wv); e < 73728; e += gridDim.x * 512) {
        const int chain = e / 1152, idx = (e % 1152) * 4, dk = idx % 48, dir = chain & 1; const size_t base = (size_t)chain * 36;
        f32x4 st = (f32x4){0.f, 0.f, 0.f, 0.f};
        for (int st0 = 0; st0 < 36; st0 += 6) { u32x2 v[6]; f32x4 d[6]; u32x2* sp[6];
#pragma unroll
            for (int u = 0; u < 6; ++u) { const int sidx = st0 + u, n = dir ? 35 - sidx : (sidx < 4 ? 32 + sidx : sidx - 4); sp[u] = (u32x2*)(S + (base + n) * 4608 + idx); v[u] = *sp[u];
                d[u] = *(const f32x4*)(DEC + (base + n) * 48 + dk); }
#pragma unroll
            for (int u = 0; u < 6; ++u) { u32x2 w; w.x = pk_bf16(st[0], st[1]); w.y = pk_bf16(st[2], st[3]); *sp[u] = w;
                st = st * d[u] + (f32x4){bflo(v[u].x), bfhi(v[u].x), bflo(v[u].y), bfhi(v[u].y)}; } }
    }
}

#define XB_TMO      128
#define XB_XCNT(j)  (256  + 64 * (j))
#define XB_XSUB(j)  (1280 + 64 * (j))
#define XB_XGEN(j)  (2304 + 64 * (j))
#define XB_TOP      3328
#define XB_TOPGEN   3392
#define XB_SPIN_CAP (1u << 22)
__device__ __forceinline__ unsigned xb_ld(unsigned* p)              { return __hip_atomic_load(p, __ATOMIC_RELAXED, __HIP_MEMORY_SCOPE_AGENT); }
__device__ __forceinline__ unsigned xb_add(unsigned* p, unsigned v) { return __hip_atomic_fetch_add(p, v, __ATOMIC_RELAXED, __HIP_MEMORY_SCOPE_AGENT); }
__device__ __forceinline__ unsigned xb_xcc_id() { return (unsigned)__builtin_amdgcn_s_getreg((3 << 11) | 20) & 0xFu; }
#define XB_SPIN(cond, bar) do { unsigned _sp = 0; while (cond) { __builtin_amdgcn_s_sleep(1); \
    if ((++_sp & 255u) == 0u) { if (xb_ld(&(bar)[XB_TMO])) break; if (_sp > XB_SPIN_CAP) { atomicAdd(&(bar)[XB_TMO], 1u); break; } } } } while (0)
__device__ __forceinline__ void xcd_barrier_complete(unsigned* bar, unsigned x, unsigned& nloc, unsigned& nx) {
    const unsigned G = gridDim.x;
    unsigned sum, cnt, mine, sp = 0u;
    for (;;) {
        sum = 0u; cnt = 0u; mine = 0u;
#pragma unroll
        for (unsigned j = 0; j < 16; ++j) { const unsigned c = xb_ld(&bar[XB_XCNT(j)]); sum += c; cnt += (c > 0u) ? 1u : 0u; mine = (j == x) ? c : mine; }
        if (sum == G) break;
        __builtin_amdgcn_s_sleep(1);
        if ((++sp & 255u) == 0u) { if (xb_ld(&bar[XB_TMO])) break; if (sp > XB_SPIN_CAP) { atomicAdd(&bar[XB_TMO], 1u); break; } }
    }
    nloc = mine > 0u ? mine : 1u; nx = cnt > 0u ? cnt : 1u;
}
__device__ __forceinline__ void grid_bar(int wv, unsigned* bar, volatile LAS unsigned* st) {
    asm volatile("s_waitcnt vmcnt(0)" ::: "memory");
    __syncthreads();
    if (otid(wv) == 0) {
        __builtin_amdgcn_s_waitcnt(0);
        const unsigned x = xb_xcc_id();
        unsigned nloc = st[0], nx = st[1];
        if (nloc == 0u) { xcd_barrier_complete(bar, x, nloc, nx); st[0] = nloc; st[1] = nx; }
        const unsigned old = xb_add(&bar[XB_XSUB(x)], 1u);
        const unsigned gen = old / nloc;
        if (old + 1u == (gen + 1u) * nloc) {
            __builtin_amdgcn_fence(__ATOMIC_RELEASE, "agent");
            asm volatile("s_waitcnt vmcnt(0)" ::: "memory");
            const unsigned og = xb_add(&bar[XB_TOP], 1u);
            const unsigned tg = og / nx;
            if (og + 1u == (tg + 1u) * nx) xb_add(&bar[XB_TOPGEN], 1u);
            else XB_SPIN(xb_ld(&bar[XB_TOPGEN]) == tg, bar);
            __builtin_amdgcn_fence(__ATOMIC_ACQUIRE, "agent");
            xb_add(&bar[XB_XGEN(x)], 1u);
            asm volatile("s_waitcnt vmcnt(0)" ::: "memory");
        } else {
            XB_SPIN(xb_ld(&bar[XB_XGEN(x)]) == gen, bar);
            __builtin_amdgcn_fence(__ATOMIC_ACQUIRE, "agent");
            asm volatile("s_waitcnt vmcnt(0)" ::: "memory");
        }
    }
    __syncthreads();
}

__global__ void __launch_bounds__(512, 2) hybrid_fwd(Params p_unused) {
    extern __shared__ __attribute__((aligned(16))) unsigned char smem[];
    LAS unsigned char* lds = (LAS unsigned char*)smem;
    const int wv = __builtin_amdgcn_readfirstlane((int)(threadIdx.x >> 6));
    const int G = gridDim.x, c = blockIdx.x;
    { volatile LAS unsigned* st = (volatile LAS unsigned*)(lds + QWORD_OFF + 4); const Params pb = ldp();
      if (otid(wv) == 0) { st[0] = 0u; st[1] = 0u; (void)xb_add((unsigned*)(pb.ws + OFF_BAR) + XB_XCNT(xb_xcc_id()), 1u); }
      __syncthreads(); }
#define GRID_SYNC() do { const Params pb = ldp(); grid_bar(wv, (unsigned*)(pb.ws + OFF_BAR), (volatile LAS unsigned*)(lds + QWORD_OFF + 4)); } while (0)

#ifndef PHM
#define PHM 0xFFFF
#endif
    if (PHM & 1) { const Params p = ldp(); phase0(wv, p, lds, c, G, 0, G == 256 ? 96 : 192, true); }
    GRID_SYNC();
#pragma nounroll
    for (int l = 0; l < 2; ++l) {
        const bool need_ctx = (l == 0);
        const int nM = need_ctx ? 72 : 64;
        if (PHM & 2) { const Params p = ldp(); phase_norm(wv, p, l, 0, MALL, l == 0 ? 0 : 5, (const float*)(p.ws + OFF_MOD) + (size_t)8 * 6144 + 5120); }
        { const Params p = ldp(); phase_weights(wv, p, l, lds, c, G); }
        GRID_SYNC();
        if (PHM & 8) { const Params p = ldp(); SchedInproj S{{need_ctx ? 792 : 768, G, c}, p.ws, need_ctx ? 0 : 1, (size_t)0 * WSET}; g8::EpiBf E; g8::gemm_phase(wv, lds, 1024, S, E); }
        if (l == 0) {
            const Params p = ldp(); if (G == 256) { if (c >= 48) trig_tables(wv, p, lds, c - 48, 208); } else trig_tables(wv, p, lds, c, G); }
        GRID_SYNC();
        { const Params p = ldp(); fourier_mid_row(wv, p); }
        if (PHM & 16) { const Params p = ldp(); SchedF1Lat S{{64, G, c}, p.ws}; g8::EpiBf E; g8::gemm_phase(wv, lds, 2048, S, E); }
        if ((PHM & 16) && need_ctx) { const Params p = ldp(); SchedF1Ctx S{{16, G, G - 1 - c}, p.ws}; g8::EpiBf E; g8::gemm_phase(wv, lds, 256, S, E); }
        { const int nNA = need_ctx ? 864 : 768, total = nNA + 1152;
          unsigned nxt_it = 0;
          const bool t0 = (otid(wv) == 0);
          if (t0) { const Params p = ldp(); nxt_it = atomicAdd((unsigned*)(p.ws + OFF_CTR) + l, 1u); }
          for (;;) {
              __syncthreads();
              if (t0) *(LAS unsigned*)(lds + QWORD_OFF) = nxt_it;
              __syncthreads();
              const int it = (int)*(LAS unsigned*)(lds + QWORD_OFF);
              if (it >= total) break;
              if (t0) { const Params p = ldp(); nxt_it = atomicAdd((unsigned*)(p.ws + OFF_CTR) + l, 1u); }
              if (it < nNA) { if (PHM & 32) { const Params p = ldp(); na_item(wv, p, l, it, lds); } } else { if (PHM & 64) { const Params p = ldp(); gla_g1_item(wv, p, l, it - nNA, lds); } }
          } }
        GRID_SYNC();
        if (PHM & 256) { const Params p = ldp(); gla_scan(wv, p); }
        GRID_SYNC();
        if (PHM & 128) { const Params p = ldp(); SchedF2 S{{nM, G, c}, p.ws, (size_t)0 * WSET}; g8::EpiBf E; g8::gemm_phase(wv, lds, 512, S, E); }
        { const int nch = need_ctx ? 36 : 32, nit = 8 * nch * 4;
          unsigned nxt_it = 0; const bool t0 = (otid(wv) == 0);
          if (t0) { const Params p = ldp(); nxt_it = atomicAdd((unsigned*)(p.ws + OFF_CTR) + 2 + l, 1u); }
          for (;;) {
              __syncthreads();
              if (t0) *(LAS unsigned*)(lds + QWORD_OFF) = nxt_it;
              __syncthreads();
              const int it = (int)*(LAS unsigned*)(lds + QWORD_OFF);
              if (it >= nit) break;
              if (t0) { const Params p = ldp(); nxt_it = atomicAdd((unsigned*)(p.ws + OFF_CTR) + 2 + l, 1u); }
              const int b = it / (nch * 4), rem = it % (nch * 4);
              if (PHM & 512) { const Params p = ldp(); gla_g3_item(wv, p, l, b, rem >> 2, rem & 3, lds); }
          } }
        GRID_SYNC();
        if (PHM & 1024) { const Params p = ldp(); const float* mod = (const float*)(p.ws + OFF_MOD); SchedRes S{G, c, need_ctx ? 1 : 0, 4, 16, 4, p.ws, (const char*)(p.ws + OFF_HY), (size_t)256 * 2048, (const char*)(p.ws + OFF_WOUT + (size_t)0 * WSET), (size_t)256 * 2048,
                     l == 0 ? (const void*)p.x : (const void*)(p.ws + OFF_XB), (void*)(p.ws + OFF_XB), l == 0 ? 2 : 3, mod + (size_t)l * 9 * 6144 + 2048};
          g8::EpiRes E; g8::gemm_phase(wv, lds, 1024, S, E); }
        GRID_SYNC();
        if (PHM & 2048) { const Params p = ldp(); phase_norm(wv, p, l, 1, nM * 256, 4, (const float*)(p.ws + OFF_MOD) + (size_t)(l * 9 + 8) * 6144 + 2048); }
        GRID_SYNC();
        if (PHM & 4096) { const Params p = ldp(); SchedFfn1 S{{nM * 22, G, c}, p.ws, (size_t)0 * WSET}; g8::EpiSwiglu E; g8::gemm_phase(wv, lds, 1024, S, E); }
        if (l == 0 && G == 256 && c >= 96) { const Params p = ldp(); phase0(wv, p, lds, c - 96, 160, 96, 192, false); }
        GRID_SYNC();
        if (PHM & 8192) { const Params p = ldp(); const float* mod = (const float*)(p.ws + OFF_MOD); SchedRes S{G, c, need_ctx ? 1 : 0, 5, 44, 8, p.ws, (const char*)(p.ws + OFF_U), (size_t)256 * DFF * 2, (const char*)(p.ws + OFF_W2 + (size_t)0 * WSET), (size_t)256 * DFF * 2,
                     (const void*)(p.ws + OFF_XB), l == 0 ? (void*)(p.ws + OFF_XB) : (void*)p.out, l == 0 ? 3 : 1, mod + (size_t)l * 9 * 6144 + 5120};
          g8::EpiRes E; g8::gemm_phase(wv, lds, DFF, S, E); }
        if (l == 0) GRID_SYNC();
    }
}

extern "C" void kernel_launch(void* const* d_in, const int* in_sizes, int n_in, void* d_out, int out_size, void* d_ws, size_t ws_size, hipStream_t stream) {
    static int grid_blocks = 0;
    if (!grid_blocks) {
        int dev = 0, cus = 0, per_cu = 0;
        (void)hipGetDevice(&dev);
        (void)hipDeviceGetAttribute(&cus, hipDeviceAttributeMultiprocessorCount, dev);
        if (hipFuncSetAttribute((const void*)hybrid_fwd, hipFuncAttributeMaxDynamicSharedMemorySize, LDS_BYTES) != hipSuccess) fprintf(stderr, "hipFuncSetAttribute failed\n");
        if (hipOccupancyMaxActiveBlocksPerMultiprocessor(&per_cu, (const void*)hybrid_fwd, 512, LDS_BYTES) != hipSuccess || per_cu < 1) { fprintf(stderr, "occupancy query: %d\n", per_cu); }
        (void)hipGetLastError();
        grid_blocks = cus > 0 ? cus : 256;
        if (ws_size < WS_END) fprintf(stderr, "workspace too small: %zu < %zu\n", ws_size, (size_t)WS_END);
    }
    Params p{};
    const float** f = (const float**)&p;
    for (int i = 0; i < 20; ++i) f[i] = (const float*)d_in[i];
    p.out = (float*)d_out; p.ws = (unsigned char*)d_ws;
    (void)hipMemsetAsync((unsigned char*)d_ws + OFF_CTR, 0, 256 + 13824, stream);
    void* args[] = {&p};
    hipError_t e = hipLaunchCooperativeKernel((void*)hybrid_fwd, dim3(grid_blocks), dim3(512), args, LDS_BYTES, stream);
    if (e != hipSuccess) fprintf(stderr, "cooperative launch failed: %s (grid %d)\n", hipGetErrorString(e), grid_blocks);
}
```
